# Optimizing an MI355X kernel written in HIP

```python
import math
import jax, jax.numpy as jnp
from jax import lax
import numpy as np

D_MODEL = 1024
BATCH = 16
SEQ = 2048
DEPTH = 4

BLOCK = 128
RET_HEADS = 4
RET_DIM = 128
SB_HEADS = 8
SB_DIM = 64
DIFF_HEADS = 8
DIFF_DIM = 64
REL_BUCKETS = 32
REL_MAX_DIST = 128
D_FF = 2816
CONV_W = 3
ALPHA = (2 * DEPTH) ** 0.25
BETA = (8 * DEPTH) ** -0.25
LN_EPS = 1e-5
ROPE_BASE = 10000.0

RET_W = RET_HEADS * RET_DIM
SB_W = SB_HEADS * SB_DIM
EVEN_IN = 4 * RET_W + 3 * SB_W
EVEN_SPLITS = [RET_W, 2 * RET_W, 3 * RET_W, 4 * RET_W, 4 * RET_W + SB_W, 4 * RET_W + 2 * SB_W]
DIFF_W = DIFF_HEADS * 2 * DIFF_DIM
ODD_IN = 3 * DIFF_W
N_EVEN = (DEPTH + 1) // 2
N_ODD = DEPTH // 2

kernel_name = "retention_stickbreak_diffattn_convffn_deepnorm"


def layer_norm(x, g, b):
    xf = x.astype(jnp.float32)
    mu = xf.mean(-1, keepdims=True)
    var = jnp.square(xf - mu).mean(-1, keepdims=True)
    return ((xf - mu) * lax.rsqrt(var + LN_EPS) * g.astype(jnp.float32) + b.astype(jnp.float32)).astype(x.dtype)


def rotary(x):
    S, dh = x.shape[1], x.shape[-1]
    inv = ROPE_BASE ** (-jnp.arange(0, dh, 2, dtype=jnp.float32) / dh)
    ang = jnp.arange(S, dtype=jnp.float32)[:, None] * inv[None, :]
    cos = jnp.cos(ang)[None, :, None, :]
    sin = jnp.sin(ang)[None, :, None, :]
    xf = x.astype(jnp.float32)
    x1, x2 = xf[..., : dh // 2], xf[..., dh // 2:]
    return jnp.concatenate([x1 * cos - x2 * sin, x1 * sin + x2 * cos], -1).astype(x.dtype)


def retention(q, k, v):
    bsz, S, H, dh = q.shape
    n = S // BLOCK
    log_g = jnp.log(1.0 - 2.0 ** (-5.0 - jnp.arange(H, dtype=jnp.float32)))
    idx = jnp.arange(BLOCK, dtype=jnp.float32)
    rel = idx[:, None] - idx[None, :]
    decay = jnp.where(rel >= 0, jnp.exp(log_g[:, None, None] * jnp.maximum(rel, 0.0)), 0.0)
    q_dec = jnp.exp(log_g[:, None] * (idx[None, :] + 1.0))
    k_dec = jnp.exp(log_g[:, None] * (BLOCK - 1.0 - idx[None, :]))
    chunk_g = jnp.exp(log_g * BLOCK)

    def chunks(t):
        return t.astype(jnp.float32).reshape(bsz, n, BLOCK, H, dh).transpose(1, 0, 3, 2, 4)

    qc, kc, vc = chunks(q), chunks(k) * (dh ** -0.5), chunks(v)

    def step(state, inp):
        qi, ki, vi = inp
        s = jnp.einsum('bhid,bhjd->bhij', qi, ki) * decay[None]
        intra = jnp.einsum('bhij,bhjd->bhid', s, vi)
        cross = jnp.einsum('bhid,bhde->bhie', qi, state) * q_dec[None, :, :, None]
        new_state = state * chunk_g[None, :, None, None] + jnp.einsum(
            'bhjd,bhje->bhde', ki * k_dec[None, :, :, None], vi)
        return new_state, intra + cross

    state0 = jnp.zeros((bsz, H, dh, dh), jnp.float32)
    _, out = lax.scan(step, state0, (qc, kc, vc))
    return out.transpose(1, 0, 3, 2, 4).reshape(bsz, S, H, dh)


def stick_breaking(q, k, v):
    bsz, S, H, dh = q.shape
    n = S // BLOCK
    qb = q.reshape(bsz, n, BLOCK, H, dh).transpose(1, 0, 3, 2, 4)
    kh = k.transpose(0, 2, 1, 3)
    vh = v.transpose(0, 2, 1, 3)
    kpos = jnp.arange(S)
    scale = dh ** -0.5

    def block(args):
        qi, start = args
        qpos = start + jnp.arange(BLOCK)
        z = jnp.einsum('bhid,bhsd->bhis', qi, kh).astype(jnp.float32) * scale
        past = (kpos[None, :] < qpos[:, None])[None, None]
        log_keep = jnp.where(past, jax.nn.log_sigmoid(-z), 0.0)
        between = lax.cumsum(log_keep, axis=3, reverse=True) - log_keep
        a = jnp.where(past, jnp.exp(jax.nn.log_sigmoid(z) + between), 0.0)
        return jnp.einsum('bhis,bhsd->bhid', a.astype(vh.dtype), vh)

    out = lax.map(block, (qb, jnp.arange(n) * BLOCK))
    return out.transpose(1, 0, 3, 2, 4).reshape(bsz, S, H * dh)


def t5_bucket(rel):
    n = jnp.maximum(rel, 0)
    max_exact = REL_BUCKETS // 2
    nf = jnp.maximum(n, 1).astype(jnp.float32)
    large = max_exact + (jnp.log(nf / max_exact) / math.log(REL_MAX_DIST / max_exact)
                         * (REL_BUCKETS - max_exact)).astype(jnp.int32)
    large = jnp.minimum(large, REL_BUCKETS - 1)
    return jnp.where(n < max_exact, n, large)


def diff_attention(q, k, v, lam, rel_bias):
    _, bsz, H, S, dh = q.shape
    n = S // BLOCK
    qb = q.reshape(2, bsz, H, n, BLOCK, dh).transpose(3, 0, 1, 2, 4, 5)
    kpos = jnp.arange(S)
    scale = dh ** -0.5
    table = rel_bias.astype(jnp.float32)

    def block(args):
        qi, start = args
        qpos = start + jnp.arange(BLOCK)
        rel = qpos[:, None] - kpos[None, :]
        bias = table[t5_bucket(rel)].transpose(2, 0, 1)
        s = jnp.einsum('pbhid,pbhsd->pbhis', qi, k).astype(jnp.float32) * scale + bias[None, None]
        s = jnp.where((rel >= 0)[None, None, None], s, -jnp.inf)
        p = jax.nn.softmax(s, axis=-1)
        w = p[0] - lam * p[1]
        return jnp.einsum('bhis,bhse->bhie', w.astype(v.dtype), v).astype(jnp.float32)

    out = lax.map(block, (qb, jnp.arange(n) * BLOCK))
    return out.transpose(1, 2, 0, 3, 4).reshape(bsz, H, S, 2 * dh)


def even_mixer(x, w_in, w_out):
    bsz, S, _ = x.shape
    h = x @ w_in
    rq, rk, rv, rg, sq, sk, sv = jnp.split(h, EVEN_SPLITS, axis=-1)
    hd = lambda t, nh, dh: t.reshape(bsz, S, nh, dh)
    ret = retention(rotary(hd(rq, RET_HEADS, RET_DIM)), rotary(hd(rk, RET_HEADS, RET_DIM)),
                    hd(rv, RET_HEADS, RET_DIM))
    mu = ret.mean(-1, keepdims=True)
    var = jnp.square(ret - mu).mean(-1, keepdims=True)
    ret = ((ret - mu) * lax.rsqrt(var + LN_EPS)).reshape(bsz, S, RET_W)
    ret = jax.nn.silu(rg.astype(jnp.float32)) * ret
    sb = stick_breaking(hd(sq, SB_HEADS, SB_DIM), hd(sk, SB_HEADS, SB_DIM), hd(sv, SB_HEADS, SB_DIM))
    y = jnp.concatenate([ret.astype(x.dtype), sb.astype(x.dtype)], axis=-1)
    return y @ w_out


def odd_mixer(x, w_in, w_out, lq1, lk1, lq2, lk2, sub_g, rel_bias, layer):
    bsz, S, _ = x.shape
    h = x @ w_in
    q, k, v = jnp.split(h, 3, axis=-1)
    q = q.reshape(bsz, S, DIFF_HEADS, 2, DIFF_DIM).transpose(3, 0, 2, 1, 4)
    k = k.reshape(bsz, S, DIFF_HEADS, 2, DIFF_DIM).transpose(3, 0, 2, 1, 4)
    v = v.reshape(bsz, S, DIFF_HEADS, 2 * DIFF_DIM).transpose(0, 2, 1, 3)
    lam_init = 0.8 - 0.6 * math.exp(-0.3 * layer)
    lam = (jnp.exp(jnp.sum(lq1.astype(jnp.float32) * lk1.astype(jnp.float32)))
           - jnp.exp(jnp.sum(lq2.astype(jnp.float32) * lk2.astype(jnp.float32))) + lam_init)
    o = diff_attention(q, k, v, lam, rel_bias)
    o = o * lax.rsqrt(jnp.square(o).mean(-1, keepdims=True) + LN_EPS) * sub_g.astype(jnp.float32)
    o = (o * (1.0 - lam_init)).transpose(0, 2, 1, 3).reshape(bsz, S, DIFF_W).astype(x.dtype)
    return o @ w_out


def conv_ffn(x, w_up, conv_w, conv_b, w_down):
    S = x.shape[1]
    h = x @ w_up
    hp = jnp.pad(h, ((0, 0), (CONV_W - 1, 0), (0, 0)))
    h = sum(hp[:, j:j + S] * conv_w[j] for j in range(CONV_W)) + conv_b
    u, g = jnp.split(h, 2, axis=-1)
    return (jax.nn.silu(g) * u) @ w_down


def setup_inputs(seed: int = 0) -> dict:
    key = jax.random.key(seed)
    ks = jax.random.split(key, 20)
    nrm = lambda k, shape, s: jax.random.normal(k, shape, jnp.float32) * s
    return {
        "x": nrm(ks[0], (BATCH, SEQ, D_MODEL), 1.0),
        "w_in_even": nrm(ks[1], (N_EVEN, D_MODEL, EVEN_IN), D_MODEL ** -0.5),
        "w_out_even": nrm(ks[2], (N_EVEN, RET_W + SB_W, D_MODEL), (RET_W + SB_W) ** -0.5 * BETA),
        "w_in_odd": nrm(ks[3], (N_ODD, D_MODEL, ODD_IN), D_MODEL ** -0.5),
        "w_out_odd": nrm(ks[4], (N_ODD, DIFF_W, D_MODEL), DIFF_W ** -0.5 * BETA),
        "lam_q1": nrm(ks[5], (N_ODD, DIFF_DIM), 0.1),
        "lam_k1": nrm(ks[6], (N_ODD, DIFF_DIM), 0.1),
        "lam_q2": nrm(ks[7], (N_ODD, DIFF_DIM), 0.1),
        "lam_k2": nrm(ks[8], (N_ODD, DIFF_DIM), 0.1),
        "subln_g": 1.0 + nrm(ks[9], (N_ODD, 2 * DIFF_DIM), 0.02),
        "rel_bias": nrm(ks[10], (REL_BUCKETS, DIFF_HEADS), 0.5),
        "w_up": nrm(ks[11], (DEPTH, D_MODEL, 2 * D_FF), D_MODEL ** -0.5),
        "conv_w": nrm(ks[12], (DEPTH, CONV_W, 2 * D_FF), CONV_W ** -0.5),
        "conv_b": nrm(ks[13], (DEPTH, 2 * D_FF), 0.02),
        "w_down": nrm(ks[14], (DEPTH, D_FF, D_MODEL), D_FF ** -0.5 * BETA),
        "ln1_g": 1.0 + nrm(ks[15], (DEPTH, D_MODEL), 0.02),
        "ln1_b": nrm(ks[16], (DEPTH, D_MODEL), 0.02),
        "ln2_g": 1.0 + nrm(ks[17], (DEPTH, D_MODEL), 0.02),
        "ln2_b": nrm(ks[18], (DEPTH, D_MODEL), 0.02),
    }


def reference(x, w_in_even, w_out_even, w_in_odd, w_out_odd, lam_q1, lam_k1, lam_q2, lam_k2,
              subln_g, rel_bias, w_up, conv_w, conv_b, w_down, ln1_g, ln1_b, ln2_g, ln2_b):
    for l in range(DEPTH):
        i = l // 2
        if l % 2 == 0:
            m = even_mixer(x, w_in_even[i], w_out_even[i])
        else:
            m = odd_mixer(x, w_in_odd[i], w_out_odd[i], lam_q1[i], lam_k1[i], lam_q2[i], lam_k2[i],
                          subln_g[i], rel_bias, l)
        x = layer_norm(ALPHA * x + m, ln1_g[l], ln1_b[l])
        f = conv_ffn(x, w_up[l], conv_w[l], conv_b[l], w_down[l])
        x = layer_norm(ALPHA * x + f, ln2_g[l], ln2_b[l])
    return x
```

```cpp
#include <hip/hip_runtime.h>
#include <hip/hip_cooperative_groups.h>
#include <cstdio>
#include <cstdint>
namespace cg = cooperative_groups;
namespace pg8 {
#define PG8_LAS __attribute__((address_space(3)))
typedef unsigned short bf16_t;
typedef short bf16x8 __attribute__((ext_vector_type(8)));
typedef float f32x4 __attribute__((ext_vector_type(4)));
typedef unsigned u32x4 __attribute__((ext_vector_type(4)));
constexpr int BM = 256, BK = 64, HALF = 128, HTB = HALF * BK * 2  , STAGE_BYTES = 8 * HTB, NXCD = 8, WGM = 8;

__host__ __device__ __forceinline__ int lds_byte(int r, int c) { const int st = (r >> 4) * 2 + (c >> 5), rr = r & 15, cc = c & 31, ob = rr * 64 + cc * 2; return st * 1024 + (ob ^ (((ob >> 9) & 1) << 5)); }
__host__ __device__ __forceinline__ void stage_rc(int b, int& R, int& C) { const int st = b / 1024, sb = b % 1024, swz = sb ^ (((sb >> 9) & 1) << 5); R = (st >> 1) * 16 + swz / 64; C = (st & 1) * 32 + (swz % 64) / 2; }
__host__ __device__ __forceinline__ int perm32(int rho) { const int n = rho >> 4, i = rho & 15; return 8 * (i >> 2) + 4 * n + (i & 3); }

struct Unit { int pm, pn; };
struct Gemm { const bf16_t* A; const bf16_t* Bt; int M, N, K; };

struct StaticOrder {
    int nM, nN, nwg, G, c;
    __host__ __device__ void init(int M, int N, int G_, int c_) { nM = M / BM; nN = N / BM; nwg = nM * nN; G = G_; c = c_; }
    __host__ __device__ bool next(int i, Unit& u) const {
        const long L = (long)i * G + c; if (L >= nwg) return false;
        int wgid = (int)L; { const int q = nwg / NXCD, r = nwg % NXCD, xcd = wgid % NXCD, off = wgid / NXCD; wgid = (xcd < r ? xcd * (q + 1) : r * (q + 1) + (xcd - r) * q) + off; }
        const int nig = WGM * nN, gid = wgid / nig, fm = gid * WGM, gsz = (nM - fm) < WGM ? (nM - fm) : WGM;
        u.pm = fm + ((wgid % nig) % gsz); u.pn = (wgid % nig) / gsz; return true;
    }
    __device__ __forceinline__ void a_ready(const Unit&) const {}
    __device__ __forceinline__ void done(const Unit&) const {}
};
__device__ __forceinline__ unsigned cvt_pk_bf16(float lo, float hi) { unsigned r; asm volatile("v_cvt_pk_bf16_f32 %0, %1, %2" : "=v"(r) : "v"(lo), "v"(hi)); return r; }
typedef float f32x2 __attribute__((ext_vector_type(2)));
struct EpiBf16 {
    static constexpr bool PERM = true, AFTER_DRAIN = false;
    bf16_t* O; int ldc;
    __device__ __forceinline__ void operator()(const f32x4 (&acc)[2][2][4][2], const Unit& u, int wr, int wc, int fr, int fq) const {
        const int row0 = u.pm * BM + wr * 64 + fr; const int col0 = u.pn * BM + wc * 32 + 8 * fq;
#pragma unroll
        for (int ai = 0; ai < 2; ++ai)
#pragma unroll
            for (int m = 0; m < 4; ++m) { bf16_t* rowp = O + (size_t)(row0 + ai * HALF + m * 16) * ldc + col0;
#pragma unroll
                for (int bj = 0; bj < 2; ++bj) { const f32x4 v0 = acc[ai][bj][m][0], v1 = acc[ai][bj][m][1];
                    u32x4 w; w.x = cvt_pk_bf16(v0[0], v0[1]); w.y = cvt_pk_bf16(v0[2], v0[3]); w.z = cvt_pk_bf16(v1[0], v1[1]); w.w = cvt_pk_bf16(v1[2], v1[3]);
                    *(u32x4*)(rowp + bj * HALF) = w; } }
    }
};
struct EpiResid {
    static constexpr bool PERM = false, AFTER_DRAIN = false;
    float* X; float alpha;
    __device__ __forceinline__ void operator()(const f32x4 (&acc)[2][2][4][2], const Unit& u, int wr, int wc, int fr, int fq) const {
        float* p = X + (size_t)(u.pm * BM + wr * 64 + fr) * 1024 + u.pn * BM + wc * 32 + 4 * fq;
#pragma unroll
        for (int ai = 0; ai < 2; ++ai)
#pragma unroll
            for (int m = 0; m < 4; ++m) { float* q = p + (ai * HALF + m * 16) * 1024;
                asm volatile("" : "+v"(q));
#pragma unroll
                for (int bj = 0; bj < 2; ++bj)
#pragma unroll
                    for (int n = 0; n < 2; ++n) { const f32x4 x = *(const f32x4*)(q + bj * HALF + n * 16);
                        *(f32x4*)(q + bj * HALF + n * 16) = acc[ai][bj][m][n] + alpha * x; }
                asm volatile("" ::: "memory"); }
    }
};
template <class Epi, class Sched, bool ALIGN_EPI = false, bool SP2 = false>
__device__ __forceinline__ void gemm_phase(PG8_LAS unsigned char* lds, const Gemm g, const Sched& S, const Epi& E) {
    int tid = threadIdx.x; asm volatile("" : "+v"(tid));
    const int wid = __builtin_amdgcn_readfirstlane(tid >> 6), lane = tid & 63, wr = wid >> 2, wc = wid & 3, fr = lane & 15, fq = lane >> 4;
    const int K = g.K, nt = K / BK;
    unsigned voffA[2], voffB[2];
#pragma unroll
    for (int i = 0; i < 2; ++i) { int R, C; stage_rc(tid * 16 + i * 8192, R, C); const int Rb = Epi::PERM ? ((R & ~31) + perm32(R & 31)) : R;
        voffA[i] = (unsigned)(R * K + C) * 2u; voffB[i] = (unsigned)(Rb * K + C) * 2u; }
    const size_t kstep = (size_t)(BK * 2);
    const size_t hstep = (size_t)HALF * K * 2;
    const size_t tstep = 2 * hstep;
    const unsigned ldsw = (unsigned)wid * 1024u;
    const int aoff = lds_byte(wr * 64 + fr, fq * 8), boff = lds_byte(wc * 32 + fr, fq * 8);
#define PG8_SA(b, h) (((b) * 2 + (h)) * HTB)
#define PG8_SB(b, h) ((4 + (b) * 2 + (h)) * HTB)
#define PG8_STAGE(bufoff, gbase, voff) do { _Pragma("unroll") for (int _i = 0; _i < 2; ++_i) \
        __builtin_amdgcn_global_load_lds((const unsigned*)((const char*)(gbase) + (voff)[_i]), (PG8_LAS unsigned*)(lds + (bufoff) + ldsw + _i * 8192), 16, 0, 0); } while (0)
#define PG8_LDA(dst, b, h) do { _Pragma("unroll") for (int m = 0; m < 4; ++m) _Pragma("unroll") for (int k = 0; k < 2; ++k) dst[m][k] = *(const PG8_LAS bf16x8*)(lds + PG8_SA(b, h) + aoff + m * 2048 + k * 1024); } while (0)
#define PG8_LDB(dst, b, h) do { _Pragma("unroll") for (int n = 0; n < 2; ++n) _Pragma("unroll") for (int k = 0; k < 2; ++k) dst[n][k] = *(const PG8_LAS bf16x8*)(lds + PG8_SB(b, h) + boff + n * 2048 + k * 1024); } while (0)
#define PG8_MMA(ai, bj, At, Bt) do { __builtin_amdgcn_s_setprio(1); _Pragma("unroll") for (int m = 0; m < 4; ++m) _Pragma("unroll") for (int n = 0; n < 2; ++n) _Pragma("unroll") for (int k = 0; k < 2; ++k) \
        acc[ai][bj][m][n] = __builtin_amdgcn_mfma_f32_16x16x32_bf16(Bt[n][k], At[m][k], acc[ai][bj][m][n], 0, 0, 0); __builtin_amdgcn_s_setprio(0); } while (0)
#define PG8_WAIT_V(n) asm volatile("s_waitcnt vmcnt(" #n ")" ::: "memory")
#define PG8_WAIT_L(n) asm volatile("s_waitcnt lgkmcnt(" #n ")" ::: "memory")
#define PG8_BAR __builtin_amdgcn_s_barrier()
#define PG8_SCHED __builtin_amdgcn_sched_barrier(0)
    Unit cur, nxt; int ui = 0;
    if (!S.next(0, cur)) return;
    f32x4 acc[2][2][4][2];
#pragma unroll
    for (int a = 0; a < 2; ++a)
#pragma unroll
        for (int b = 0; b < 2; ++b)
#pragma unroll
            for (int m = 0; m < 4; ++m)
#pragma unroll
                for (int n = 0; n < 2; ++n) acc[a][b][m][n] = (f32x4){0.f, 0.f, 0.f, 0.f};
    bf16x8 At[4][2], B0[2][2], B1[2][2];
    const char* cA = (const char*)g.A + (size_t)cur.pm * tstep; const char* cB = (const char*)g.Bt + (size_t)cur.pn * tstep;
    S.a_ready(cur);
    if constexpr (SP2) {
        PG8_STAGE(PG8_SB(0, 0), cB, voffB); PG8_STAGE(PG8_SB(0, 1), cB + hstep, voffB); PG8_STAGE(PG8_SA(0, 0), cA, voffA); PG8_STAGE(PG8_SA(0, 1), cA + hstep, voffA);
        if (wr == 1) PG8_BAR;
        PG8_WAIT_V(2); PG8_BAR;
        PG8_STAGE(PG8_SB(1, 0), cB + kstep, voffB); PG8_STAGE(PG8_SA(1, 0), cA + kstep, voffA); PG8_STAGE(PG8_SB(1, 1), cB + hstep + kstep, voffB);
        PG8_WAIT_V(6); PG8_BAR;
    } else {
        PG8_STAGE(PG8_SB(0, 0), cB, voffB); PG8_STAGE(PG8_SA(0, 0), cA, voffA); PG8_STAGE(PG8_SB(0, 1), cB + hstep, voffB); PG8_STAGE(PG8_SA(0, 1), cA + hstep, voffA);
        if (wr == 1) PG8_BAR;
        PG8_WAIT_V(4); PG8_BAR;
        PG8_STAGE(PG8_SB(1, 0), cB + kstep, voffB); PG8_STAGE(PG8_SA(1, 0), cA + kstep, voffA); PG8_STAGE(PG8_SB(1, 1), cB + hstep + kstep, voffB);
        PG8_WAIT_V(6); PG8_BAR;
    }
    for (;;) {
        const bool has_next = S.next(ui + 1, nxt);
        const char* nA = has_next ? (const char*)g.A + (size_t)nxt.pm * tstep : cA; const char* nB = has_next ? (const char*)g.Bt + (size_t)nxt.pn * tstep : cB;
        for (int t = 0; t < nt; t += 2) {
            const bool last = (t == nt - 2);
            const char* a1 = cA + (size_t)(t + 1) * kstep;
            const char* a2 = last ? nA : cA + (size_t)(t + 2) * kstep; const char* b2 = last ? nB : cB + (size_t)(t + 2) * kstep;
            const char* a3 = a2 + kstep; const char* b3 = b2 + kstep;
            if (last && has_next) S.a_ready(nxt);
            if constexpr (SP2) {
            PG8_LDB(B0, 0, 0); PG8_LDB(B1, 0, 1); PG8_SCHED; PG8_LDA(At, 0, 0); PG8_STAGE(PG8_SA(1, 1), a1 + hstep, voffA);
            PG8_WAIT_V(8); PG8_WAIT_L(0); PG8_BAR; PG8_MMA(0, 0, At, B0); PG8_MMA(0, 1, At, B1); PG8_BAR; PG8_SCHED;
            PG8_LDA(At, 0, 1); PG8_STAGE(PG8_SB(0, 0), b2, voffB); PG8_STAGE(PG8_SB(0, 1), b2 + hstep, voffB); PG8_STAGE(PG8_SA(0, 0), a2, voffA);
            PG8_WAIT_V(8); PG8_WAIT_L(0); PG8_BAR; PG8_MMA(1, 0, At, B0); PG8_MMA(1, 1, At, B1); PG8_BAR; PG8_SCHED;
            PG8_LDB(B0, 1, 0); PG8_LDB(B1, 1, 1); PG8_SCHED; PG8_LDA(At, 1, 0); PG8_STAGE(PG8_SA(0, 1), a2 + hstep, voffA);
            PG8_WAIT_V(8); PG8_WAIT_L(0); PG8_BAR; PG8_MMA(0, 0, At, B0); PG8_MMA(0, 1, At, B1); PG8_BAR; PG8_SCHED;
            PG8_LDA(At, 1, 1); PG8_STAGE(PG8_SB(1, 0), b3, voffB); PG8_STAGE(PG8_SB(1, 1), b3 + hstep, voffB); PG8_STAGE(PG8_SA(1, 0), a3, voffA);
            PG8_WAIT_V(8); PG8_WAIT_L(0); PG8_BAR; PG8_MMA(1, 0, At, B0); PG8_MMA(1, 1, At, B1); PG8_BAR; PG8_SCHED;
            } else {
            PG8_LDB(B0, 0, 0); PG8_SCHED; PG8_LDA(At, 0, 0); PG8_STAGE(PG8_SA(1, 1), a1 + hstep, voffA);
            PG8_WAIT_L(8); PG8_BAR; PG8_WAIT_L(0); PG8_MMA(0, 0, At, B0); PG8_BAR; PG8_SCHED;
            PG8_LDB(B1, 0, 1); PG8_STAGE(PG8_SB(0, 0), b2, voffB);
            PG8_BAR; PG8_WAIT_L(0); PG8_MMA(0, 1, At, B1); PG8_BAR;
            PG8_LDA(At, 0, 1); PG8_STAGE(PG8_SA(0, 0), a2, voffA);
            PG8_BAR; PG8_WAIT_L(0); PG8_MMA(1, 0, At, B0); PG8_BAR; PG8_SCHED;
            PG8_STAGE(PG8_SB(0, 1), b2 + hstep, voffB);
            PG8_WAIT_V(6); PG8_BAR; PG8_MMA(1, 1, At, B1); PG8_BAR;
            PG8_LDB(B0, 1, 0); PG8_SCHED; PG8_LDA(At, 1, 0); PG8_STAGE(PG8_SA(0, 1), a2 + hstep, voffA);
            PG8_WAIT_L(8); PG8_BAR; PG8_WAIT_L(0); PG8_MMA(0, 0, At, B0); PG8_BAR; PG8_SCHED;
            PG8_LDB(B1, 1, 1); PG8_STAGE(PG8_SB(1, 0), b3, voffB);
            PG8_BAR; PG8_WAIT_L(0); PG8_MMA(0, 1, At, B1); PG8_BAR;
            PG8_LDA(At, 1, 1); PG8_STAGE(PG8_SA(1, 0), a3, voffA);
            PG8_BAR; PG8_WAIT_L(0); PG8_MMA(1, 0, At, B0); PG8_BAR; PG8_SCHED;
            PG8_STAGE(PG8_SB(1, 1), b3 + hstep, voffB);
            PG8_WAIT_V(6); PG8_BAR; PG8_MMA(1, 1, At, B1); PG8_BAR;
            }
        }
        if constexpr (ALIGN_EPI) { if (wr == 0) PG8_BAR; }
        if constexpr (!Epi::AFTER_DRAIN) { E(acc, cur, wr, wc, fr, fq); S.done(cur); }
        if (!has_next) break;
#pragma unroll
        for (int a = 0; a < 2; ++a)
#pragma unroll
            for (int b = 0; b < 2; ++b)
#pragma unroll
                for (int m = 0; m < 4; ++m)
#pragma unroll
                    for (int n = 0; n < 2; ++n) acc[a][b][m][n] = (f32x4){0.f, 0.f, 0.f, 0.f};
        cur = nxt; cA = nA; cB = nB; ++ui;
        if constexpr (ALIGN_EPI) { if (wr == 1) PG8_BAR; }
    }
    PG8_WAIT_V(0);
    if constexpr (!ALIGN_EPI) { if (wr == 0) PG8_BAR; }
    PG8_BAR;
    if constexpr (Epi::AFTER_DRAIN) { E.fused(acc, cur, wr, wc, fr, fq, lds, wid, lane); S.done(cur); }
#undef PG8_SA
#undef PG8_SB
#undef PG8_STAGE
#undef PG8_LDA
#undef PG8_LDB
#undef PG8_MMA
#undef PG8_WAIT_V
#undef PG8_WAIT_L
#undef PG8_BAR
#undef PG8_SCHED
}
}

#define DI __device__ __forceinline__
#define LAS __attribute__((address_space(3)))
using pg8::bf16_t; using pg8::bf16x8; using pg8::f32x4; using pg8::u32x4; using pg8::cvt_pk_bf16;
typedef short s16x4 __attribute__((ext_vector_type(4)));
typedef float f32x16 __attribute__((ext_vector_type(16)));
typedef unsigned u32x2 __attribute__((ext_vector_type(2)));

constexpr int D_MODEL = 1024, BATCH = 16, SEQ = 2048, DEPTH = 4, MTOK = BATCH * SEQ;
constexpr int D_FF = 2816, FF2 = 2 * D_FF, EVEN_IN = 3584, ODD_IN = 3072;
constexpr float ALPHA = 1.681792830507f, LN_EPS = 1e-5f, LOG2E = 1.4426950408889634f;
constexpr int NWAVES = 8, NTHR = 512;
constexpr int LDS_BYTES = 147456;
constexpr int HALF_ROWS = MTOK / 2;

constexpr size_t MiB = 1u << 20;
constexpr size_t WS_CTL = 0, WS_ROPE = 1 * MiB, WS_WIN = 2 * MiB, WS_WOUT = 10 * MiB, WS_WUP = 12 * MiB, WS_WDN = 24 * MiB;
constexpr size_t WS_XB = 32 * MiB, WS_H = 96 * MiB, WS_Y = 320 * MiB, WS_HUP = 96 * MiB, WS_A = 272 * MiB, WS_END = 448 * MiB;

__device__ const float ROPE_INV[64] = {
1.000000000e+00f, 8.659643531e-01f, 7.498942614e-01f, 6.493816376e-01f, 5.623413324e-01f, 4.869675338e-01f, 4.216965139e-01f, 3.651741147e-01f, 3.162277639e-01f, 2.738419771e-01f, 2.371373773e-01f, 2.053525001e-01f, 1.778279394e-01f, 1.539926529e-01f, 1.333521307e-01f, 1.154782027e-01f, 1.000000015e-01f, 8.659642935e-02f, 7.498941571e-02f, 6.493816525e-02f, 5.623413250e-02f, 4.869675264e-02f, 4.216965288e-02f, 3.651741147e-02f, 3.162277490e-02f, 2.738419734e-02f, 2.371373773e-02f, 2.053525113e-02f, 1.778279431e-02f, 1.539926510e-02f, 1.333521493e-02f, 1.154782064e-02f, 9.999999776e-03f, 8.659643121e-03f, 7.498941850e-03f, 6.493816152e-03f, 5.623413250e-03f, 4.869675264e-03f, 4.216964822e-03f, 3.651741194e-03f, 3.162277630e-03f, 2.738419687e-03f, 2.371373586e-03f, 2.053524833e-03f, 1.778279431e-03f, 1.539926510e-03f, 1.333521446e-03f, 1.154781901e-03f, 1.000000047e-03f, 8.659643354e-04f, 7.498942432e-04f, 6.493816618e-04f, 5.623413017e-04f, 4.869675322e-04f, 4.216965172e-04f, 3.651741426e-04f, 3.162277571e-04f, 2.738419571e-04f, 2.371373703e-04f, 2.053525095e-04f, 1.778279402e-04f, 1.539926452e-04f, 1.333521504e-04f, 1.154782003e-04f };
__device__ const unsigned char T5B[129] = {
0, 1, 2, 3, 4, 5, 6, 7, 8, 9, 10, 11, 12, 13, 14, 15, 16, 16, 16, 17, 17, 18, 18, 18, 19, 19, 19, 20, 20, 20, 20, 21, 21, 21, 21, 22, 22, 22, 22, 22, 23, 23, 23, 23, 23, 23, 24, 24, 24, 24, 24, 24, 25, 25, 25, 25, 25, 25, 25, 26, 26, 26, 26, 26, 26, 26, 26, 27, 27, 27, 27, 27, 27, 27, 27, 27, 27, 28, 28, 28, 28, 28, 28, 28, 28, 28, 28, 29, 29, 29, 29, 29, 29, 29, 29, 29, 29, 29, 29, 30, 30, 30, 30, 30, 30, 30, 30, 30, 30, 30, 30, 30, 30, 31, 31, 31, 31, 31, 31, 31, 31, 31, 31, 31, 31, 31, 31, 31, 31 };

struct Args { const float* in[19]; float* out; unsigned char* ws; };
#define OPAQUE(p) asm volatile("" : "+s"(p))
#define PHASE_IDS int tid = threadIdx.x; asm volatile("" : "+v"(tid)); const int lane = tid & 63, wid = __builtin_amdgcn_readfirstlane(tid >> 6); (void)lane; (void)wid

DI float bflo(unsigned w) { return __uint_as_float(w << 16); }
DI float bfhi(unsigned w) { return __uint_as_float(w & 0xffff0000u); }
DI float wave_sum(float v) {
#pragma unroll
    for (int o = 1; o < 64; o <<= 1) v += __shfl_xor(v, o);
    return v;
}
DI unsigned f2bf(float f) { unsigned u = __float_as_uint(f); return (u + 0x7fffu + ((u >> 16) & 1u)) >> 16; }
DI unsigned pk2(float lo, float hi) { return f2bf(lo) | (f2bf(hi) << 16); }

DI void transpose_item(const float* W, int K, int N, bf16_t* WT, LAS float* scr, int item, int lane) {
    const int nblk = N / 32, kb = item / nblk, nb = item % nblk, k0 = 64 * kb, n0 = 32 * nb;
#pragma unroll 8
    for (int i = 0; i < 32; ++i) { const int kk = 2 * i + (lane >> 5); scr[kk * 33 + (lane & 31)] = W[(size_t)(k0 + kk) * N + n0 + (lane & 31)]; }
    asm volatile("s_waitcnt lgkmcnt(0)" ::: "memory");
    const int c = lane & 7;
#pragma unroll
    for (int j = 0; j < 4; ++j) { const int n = (lane >> 3) + 8 * j; const LAS float* s = scr + (8 * c) * 33 + n;
        u32x4 o; o.x = pk2(s[0 * 33], s[1 * 33]); o.y = pk2(s[2 * 33], s[3 * 33]); o.z = pk2(s[4 * 33], s[5 * 33]); o.w = pk2(s[6 * 33], s[7 * 33]);
        *(u32x4*)(WT + (size_t)(n0 + n) * K + k0 + 8 * c) = o; }
    asm volatile("s_waitcnt lgkmcnt(0)" ::: "memory");
}
DI void convert_weights(const Args& a, int l, LAS unsigned char* lds) {
    PHASE_IDS;
    LAS float* scr = (LAS float*)(lds + wid * 16384);
    const int gw = blockIdx.x * NWAVES + wid, NGW = gridDim.x * NWAVES;
    const int li = l >> 1; const bool even = (l & 1) == 0;
    const int Nin = even ? EVEN_IN : ODD_IN;
    const float* Win = even ? a.in[1] + (size_t)li * D_MODEL * EVEN_IN : a.in[3] + (size_t)li * D_MODEL * ODD_IN;
    const float* Wout = (even ? a.in[2] : a.in[4]) + (size_t)li * D_MODEL * D_MODEL;
    const float* Wup = a.in[11] + (size_t)l * D_MODEL * FF2;
    const float* Wdn = a.in[14] + (size_t)l * D_FF * D_MODEL;
    bf16_t* Win_t = (bf16_t*)(a.ws + WS_WIN); bf16_t* Wout_t = (bf16_t*)(a.ws + WS_WOUT); bf16_t* Wup_t = (bf16_t*)(a.ws + WS_WUP); bf16_t* Wdn_t = (bf16_t*)(a.ws + WS_WDN);
    const int I_in = (D_MODEL / 64) * (Nin / 32), I_out = (D_MODEL / 64) * (D_MODEL / 32), I_up = (D_MODEL / 64) * (FF2 / 32), I_dn = (D_FF / 64) * (D_MODEL / 32);
    const int NIT = I_in + I_out + I_up + I_dn;
    for (int it = gw; it < NIT; it += NGW) {
        int r = it;
        if (r < I_in) { transpose_item(Win, D_MODEL, Nin, Win_t, scr, r, lane); continue; } r -= I_in;
        if (r < I_out) { transpose_item(Wout, D_MODEL, D_MODEL, Wout_t, scr, r, lane); continue; } r -= I_out;
        if (r < I_up) { transpose_item(Wup, D_MODEL, FF2, Wup_t, scr, r, lane); continue; } r -= I_up;
        transpose_item(Wdn, D_FF, D_MODEL, Wdn_t, scr, r, lane);
    }
}
DI void prologue(const Args& a, LAS unsigned char* lds) {
    PHASE_IDS;
    if (blockIdx.x == 0 && tid < 64) ((unsigned*)(a.ws + WS_CTL))[tid * 64] = 0u;
    convert_weights(a, 0, lds);
    { const f32x4* x4 = (const f32x4*)a.in[0]; u32x2* o = (u32x2*)(a.ws + WS_XB);
      const size_t n4 = (size_t)MTOK * D_MODEL / 4;
      for (size_t i = (size_t)blockIdx.x * NTHR + tid; i < n4; i += (size_t)gridDim.x * NTHR) { const f32x4 v = x4[i]; u32x2 w; w.x = cvt_pk_bf16(v[0], v[1]); w.y = cvt_pk_bf16(v[2], v[3]); o[i] = w; ((f32x4*)a.out)[i] = v; } }
    { float* rp = (float*)(a.ws + WS_ROPE);
      for (int i = blockIdx.x * NTHR + tid; i < SEQ * 64; i += gridDim.x * NTHR) {
          const int pos = i >> 6, fi = i & 63;
          const float ang = (float)pos * ROPE_INV[fi];
          const double rev = (double)ang * 0.15915494309189535; const double fr = rev - __builtin_rint(rev);
          const float f = (float)fr;
          rp[2 * i] = __builtin_amdgcn_cosf(f); rp[2 * i + 1] = __builtin_amdgcn_sinf(f); } }
}

DI void ln_phase(float* X, bf16_t* XB, const float* g, const float* bt) {
    PHASE_IDS;
    const int gw = blockIdx.x * NWAVES + wid, NGW = gridDim.x * NWAVES;
    f32x4 gg[4], bb[4];
#pragma unroll
    for (int j = 0; j < 4; ++j) { gg[j] = ((const f32x4*)g)[lane + 64 * j]; bb[j] = ((const f32x4*)bt)[lane + 64 * j]; }
    for (int row = gw; row < MTOK; row += NGW) {
        f32x4* xr = (f32x4*)(X + (size_t)row * D_MODEL) + lane;
        f32x4 v[4]; float s = 0.f;
#pragma unroll
        for (int j = 0; j < 4; ++j) { v[j] = xr[64 * j]; s += (v[j][0] + v[j][1]) + (v[j][2] + v[j][3]); }
        const float mean = wave_sum(s) * (1.f / D_MODEL); float s2 = 0.f;
#pragma unroll
        for (int j = 0; j < 4; ++j) { v[j] = v[j] - mean; s2 += (v[j][0] * v[j][0] + v[j][1] * v[j][1]) + (v[j][2] * v[j][2] + v[j][3] * v[j][3]); }
        const float rstd = 1.f / sqrtf(wave_sum(s2) * (1.f / D_MODEL) + LN_EPS);
        u32x2* o8 = (u32x2*)(XB + (size_t)row * D_MODEL) + lane;
#pragma unroll
        for (int j = 0; j < 4; ++j) { const f32x4 o = v[j] * rstd * gg[j] + bb[j]; xr[64 * j] = o;
            u32x2 w; w.x = cvt_pk_bf16(o[0], o[1]); w.y = cvt_pk_bf16(o[2], o[3]); o8[64 * j] = w; }
    }
}

DI void conv8(const u32x4 h0, const u32x4 h1, const u32x4 h2, const float* cw, const float* cb, float (&o)[8]) {
    float w0[8], w1[8], w2[8], bb[8];
#pragma unroll
    for (int q = 0; q < 2; ++q) {
        const f32x4 a0 = *(const f32x4*)(cw + 4 * q), a1 = *(const f32x4*)(cw + FF2 + 4 * q), a2 = *(const f32x4*)(cw + 2 * FF2 + 4 * q), ab = *(const f32x4*)(cb + 4 * q);
#pragma unroll
        for (int e = 0; e < 4; ++e) { w0[4 * q + e] = a0[e]; w1[4 * q + e] = a1[e]; w2[4 * q + e] = a2[e]; bb[4 * q + e] = ab[e]; }
    }
#pragma unroll
    for (int k = 0; k < 4; ++k) {
        o[2 * k] = w2[2 * k] * bflo(h0[k]) + w1[2 * k] * bflo(h1[k]) + w0[2 * k] * bflo(h2[k]) + bb[2 * k];
        o[2 * k + 1] = w2[2 * k + 1] * bfhi(h0[k]) + w1[2 * k + 1] * bfhi(h1[k]) + w0[2 * k + 1] * bfhi(h2[k]) + bb[2 * k + 1];
    }
}
DI void convgate_phase(const bf16_t* HUP, bf16_t* A, const float* cw, const float* cb, int half) {
    PHASE_IDS;
    constexpr int NCH = D_FF / 8;
    const int total = HALF_ROWS * NCH;
    for (int idx = blockIdx.x * NTHR + tid; idx < total; idx += gridDim.x * NTHR) {
        const int rl = idx / NCH, ch = idx - rl * NCH, c = ch * 8, tin = rl & (SEQ - 1);
        const bf16_t* hp = HUP + (size_t)rl * FF2 + c;
        const u32x4 z = {0u, 0u, 0u, 0u};
        const u32x4 u0 = *(const u32x4*)hp, g0 = *(const u32x4*)(hp + D_FF);
        const u32x4 u1 = tin >= 1 ? *(const u32x4*)(hp - FF2) : z, g1 = tin >= 1 ? *(const u32x4*)(hp - FF2 + D_FF) : z;
        const u32x4 u2 = tin >= 2 ? *(const u32x4*)(hp - 2 * FF2) : z, g2 = tin >= 2 ? *(const u32x4*)(hp - 2 * FF2 + D_FF) : z;
        float uo[8], go[8];
        conv8(u0, u1, u2, cw + c, cb + c, uo);
        conv8(g0, g1, g2, cw + D_FF + c, cb + D_FF + c, go);
        float r[8];
#pragma unroll
        for (int j = 0; j < 8; ++j) { const float gv = go[j]; r[j] = gv / (1.f + __expf(-gv)) * uo[j]; }
        u32x4 w; w.x = cvt_pk_bf16(r[0], r[1]); w.y = cvt_pk_bf16(r[2], r[3]); w.z = cvt_pk_bf16(r[4], r[5]); w.w = cvt_pk_bf16(r[6], r[7]);
        *(u32x4*)(A + ((size_t)half * HALF_ROWS + rl) * D_FF + c) = w;
    }
}

#define MFMA32(a, b, c) __builtin_amdgcn_mfma_f32_32x32x16_bf16((a), (b), (c), 0, 0, 0)
DI bf16x8 pack8(float f0, float f1, float f2, float f3, float f4, float f5, float f6, float f7) {
    u32x4 p; p.x = cvt_pk_bf16(f0, f1); p.y = cvt_pk_bf16(f2, f3); p.z = cvt_pk_bf16(f4, f5); p.w = cvt_pk_bf16(f6, f7);
    return __builtin_bit_cast(bf16x8, p);
}
DI void rot8(u32x4& a, u32x4& b, const float* tab) {
    const f32x4 t0 = *(const f32x4*)tab, t1 = *(const f32x4*)(tab + 4), t2 = *(const f32x4*)(tab + 8), t3 = *(const f32x4*)(tab + 12);
    float o1[8], o2[8];
#pragma unroll
    for (int k = 0; k < 4; ++k) {
        const f32x4 tt = k == 0 ? t0 : (k == 1 ? t1 : (k == 2 ? t2 : t3));
        const float x1l = bflo(a[k]), x1h = bfhi(a[k]), x2l = bflo(b[k]), x2h = bfhi(b[k]);
        o1[2 * k] = x1l * tt[0] - x2l * tt[1]; o2[2 * k] = x1l * tt[1] + x2l * tt[0];
        o1[2 * k + 1] = x1h * tt[2] - x2h * tt[3]; o2[2 * k + 1] = x1h * tt[3] + x2h * tt[2];
    }
    a.x = cvt_pk_bf16(o1[0], o1[1]); a.y = cvt_pk_bf16(o1[2], o1[3]); a.z = cvt_pk_bf16(o1[4], o1[5]); a.w = cvt_pk_bf16(o1[6], o1[7]);
    b.x = cvt_pk_bf16(o2[0], o2[1]); b.y = cvt_pk_bf16(o2[2], o2[3]); b.z = cvt_pk_bf16(o2[4], o2[5]); b.w = cvt_pk_bf16(o2[6], o2[7]);
}

template <int MODE>
DI void attn_unit(LAS unsigned char* lds, const Args& a, const bf16_t* __restrict__ H, const int pitch, bf16_t* __restrict__ Y,
                  const int b, const int hd, const int qb, const int layer) {
    constexpr int KD = (MODE == 1) ? 64 : 128, DV = (MODE == 1) ? 64 : 128, NQS = KD / 16, NDT = DV / 32, NMAP = (MODE == 2) ? 2 : 1;
    constexpr int KP = KD * 2 + 16, VP = 64 * 2 + 8, BUFB = 36864, VOFF = 18432;
    int tid = threadIdx.x; asm volatile("" : "+v"(tid));
    const int lane = tid & 63, wid = __builtin_amdgcn_readfirstlane(tid >> 6), r = lane & 31, hh = lane >> 5;
    int qcol, kcol, vcol, ycol;
    if (MODE == 0) { qcol = hd * 128; kcol = 512 + hd * 128; vcol = 1024 + hd * 128; ycol = hd * 128; }
    else if (MODE == 1) { qcol = 2048 + hd * 64; kcol = 2560 + hd * 64; vcol = 3072 + hd * 64; ycol = 512 + hd * 64; }
    else { qcol = hd * 128; kcol = 1024 + hd * 128; vcol = 2048 + hd * 128; ycol = hd * 128; }
    const size_t rowb = (size_t)b * SEQ;
    const int t0 = qb * 256 + wid * 32, t = t0 + r;
    const float* rope = (const float*)(a.ws + WS_ROPE);
    LAS float* biasT = (LAS float*)(lds + 81920);
    if (MODE == 2) { if (tid < 129) biasT[tid] = a.in[10][(int)T5B[tid] * 8 + hd] * LOG2E; }

    u32x4 qf[NQS];
    { const bf16_t* qp = H + (rowb + t) * pitch + qcol + 8 * hh;
#pragma unroll
      for (int st = 0; st < NQS; ++st) qf[st] = *(const u32x4*)(qp + 16 * st); }
    if (MODE == 0) {
#pragma unroll
        for (int st = 0; st < 4; ++st) rot8(qf[st], qf[st + 4], rope + ((size_t)t * 64 + 16 * st + 8 * hh) * 2);
    }
    const int ks = tid >> 3, kc = tid & 7;
    const bf16_t* kg = H + (rowb + ks) * pitch + kcol + 8 * kc;
    const int vdb = (DV == 128) ? 16 * wid : 8 * wid;
    const bf16_t* vg = H + (rowb + lane) * pitch + vcol + vdb;
    u32x4 kr0, kr1, vr0, vr1;
    kr1 = (u32x4){0u, 0u, 0u, 0u}; vr1 = kr1;
#define LOAD_TILE(kt) do { const size_t off_ = (size_t)(kt) * 64 * pitch; kr0 = *(const u32x4*)(kg + off_); if (KD == 128) kr1 = *(const u32x4*)(kg + off_ + 64); \
        vr0 = *(const u32x4*)(vg + off_); if (DV == 128) vr1 = *(const u32x4*)(vg + off_ + 8); } while (0)
#define WRITE_TILE(kt, buf) do { LAS unsigned char* Kb_ = lds + (buf) * BUFB; LAS unsigned char* Vb_ = Kb_ + VOFF; \
        if (MODE == 0) rot8(kr0, kr1, rope + ((size_t)((kt) * 64 + ks) * 64 + 8 * kc) * 2); \
        *(LAS u32x4*)(Kb_ + ks * KP + kc * 16) = kr0; if (KD == 128) *(LAS u32x4*)(Kb_ + ks * KP + 128 + kc * 16) = kr1; \
        _Pragma("unroll") for (int i_ = 0; i_ < 4; ++i_) { \
            *(LAS unsigned short*)(Vb_ + (vdb + 2 * i_) * VP + lane * 2) = (unsigned short)(vr0[i_] & 0xffffu); \
            *(LAS unsigned short*)(Vb_ + (vdb + 2 * i_ + 1) * VP + lane * 2) = (unsigned short)(vr0[i_] >> 16); \
            if (DV == 128) { *(LAS unsigned short*)(Vb_ + (vdb + 8 + 2 * i_) * VP + lane * 2) = (unsigned short)(vr1[i_] & 0xffffu); \
                             *(LAS unsigned short*)(Vb_ + (vdb + 8 + 2 * i_ + 1) * VP + lane * 2) = (unsigned short)(vr1[i_] >> 16); } } } while (0)

    f32x16 oacc[NDT];
#pragma unroll
    for (int dt = 0; dt < NDT; ++dt)
#pragma unroll
        for (int i = 0; i < 16; ++i) oacc[dt][i] = 0.f;
    float mrun[NMAP], lrun[NMAP], cmul[NMAP];
#pragma unroll
    for (int p = 0; p < NMAP; ++p) { mrun[p] = -INFINITY; lrun[p] = 0.f; cmul[p] = 0.f; }
    float Rrun = 0.f;
    const float lg2 = (MODE == 0) ? (hd == 0 ? -4.580368961312e-02f : (hd == 1 ? -2.272007650008e-02f : (hd == 2 ? -1.131531322783e-02f : -5.646563141142e-03f))) : 0.f;
    const float lam_init = (layer == 1) ? 0.3555090676f : 0.5560582042f;

    const int nkt = qb * 4 + 4;
    constexpr int NPASS = (MODE == 2) ? 2 : 1;
    for (int pass = 0; pass < NPASS; ++pass) {
    const bool statpass = (MODE == 2) && (pass == 0);
    if (MODE == 2 && pass == 1) {
        const int li = layer >> 1;
        const float d1 = wave_sum(a.in[5][li * 64 + lane] * a.in[6][li * 64 + lane]);
        const float d2 = wave_sum(a.in[7][li * 64 + lane] * a.in[8][li * 64 + lane]);
        const float lam = expf(d1) - expf(d2) + lam_init;
        cmul[0] = 1.f / lrun[0]; cmul[NMAP - 1] = lam / lrun[NMAP - 1];
    }
    if (MODE != 2) LOAD_TILE(nkt - 1);
    for (int it = 0; it < nkt; ++it) {
        const int kt = nkt - 1 - it, buf = it & 1;
        if (MODE == 2) LOAD_TILE(kt);
        WRITE_TILE(kt, buf);
        __syncthreads();
        if (MODE != 2 && it + 1 < nkt) LOAD_TILE(kt - 1);
        LAS unsigned char* Kb = lds + buf * BUFB; LAS unsigned char* Vb = Kb + VOFF;
#pragma unroll 1
        for (int subi = 0; subi < 2; ++subi) {
            const int sub = 1 - subi;
            const int s0 = kt * 64 + 32 * sub;
            if (s0 > t0) continue;
            const int relb = t0 - s0 + r - 4 * hh;
            __builtin_amdgcn_sched_barrier(0);
            float pv[16];
#pragma unroll
            for (int p = 0; p < NMAP; ++p) {
                f32x16 sacc;
#pragma unroll
                for (int i = 0; i < 16; ++i) sacc[i] = 0.f;
                constexpr int NST = NQS / NMAP;
#pragma unroll
                for (int st = 0; st < NST; ++st) {
                    const int sq = p * NST + st;
                    const bf16x8 kf = *(const LAS bf16x8*)(Kb + (32 * sub + r) * KP + (16 * sq + 8 * hh) * 2);
                    sacc = MFMA32(kf, __builtin_bit_cast(bf16x8, qf[sq]), sacc);
                }
                if (MODE == 0) {
#pragma unroll
                    for (int i = 0; i < 16; ++i) { const int rel = relb - ((i & 3) + 8 * (i >> 2));
                        const float f = __builtin_amdgcn_exp2f((float)rel * lg2) * 0.08838834764831845f;
                        pv[i] = (rel >= 0) ? sacc[i] * f : 0.f; }
                } else if (MODE == 1) {
                    float L[16], ls[16], c[16], gs[4], pg[4], suf[4];
#pragma unroll
                    for (int i = 0; i < 16; ++i) { const int rel = relb - ((i & 3) + 8 * (i >> 2));
                        const float z = sacc[i] * 0.125f; const float lp = __logf(1.f + __expf(-fabsf(z)));
                        const float lsi = fminf(z, 0.f) - lp; ls[i] = lsi; L[i] = (rel > 0) ? (lsi - z) : 0.f; }
#pragma unroll
                    for (int g = 0; g < 4; ++g) { c[4 * g + 3] = 0.f; c[4 * g + 2] = L[4 * g + 3]; c[4 * g + 1] = c[4 * g + 2] + L[4 * g + 2]; c[4 * g] = c[4 * g + 1] + L[4 * g + 1];
                        gs[g] = c[4 * g] + L[4 * g]; pg[g] = __shfl_xor(gs[g], 32); }
                    float run = 0.f;
#pragma unroll
                    for (int g = 3; g >= 0; --g) { suf[g] = run + (hh == 0 ? pg[g] : 0.f); run += gs[g] + pg[g]; }
#pragma unroll
                    for (int i = 0; i < 16; ++i) { const int rel = relb - ((i & 3) + 8 * (i >> 2));
                        const float e = __expf(ls[i] + Rrun + suf[i >> 2] + c[i]); pv[i] = (rel > 0) ? e : 0.f; }
                    Rrun += run;
                } else {
                    const bool far = (t0 - s0 - 31) >= 128;
                    float sv[16]; float mx = -INFINITY;
#pragma unroll
                    for (int i = 0; i < 16; ++i) { const int rel = relb - ((i & 3) + 8 * (i >> 2));
                        const int ri = far ? 128 : (rel < 0 ? 0 : (rel > 128 ? 128 : rel));
                        float v = sacc[i] * (0.125f * LOG2E) + biasT[ri];
                        if (rel < 0) v = -INFINITY;
                        sv[i] = v; mx = fmaxf(mx, v); }
                    if (statpass) {
                        mx = fmaxf(mx, __shfl_xor(mx, 32));
                        const float mnew = fmaxf(mrun[p], mx);
                        const float al = __builtin_amdgcn_exp2f(mrun[p] - mnew);
                        float sm = 0.f;
#pragma unroll
                        for (int i = 0; i < 16; ++i) sm += __builtin_amdgcn_exp2f(sv[i] - mnew);
                        sm += __shfl_xor(sm, 32);
                        lrun[p] = lrun[p] * al + sm; mrun[p] = mnew;
                    } else {
                        const float mm = mrun[p], cc = cmul[p];
                        if (p == 0) {
#pragma unroll
                            for (int i = 0; i < 16; ++i) pv[i] = __builtin_amdgcn_exp2f(sv[i] - mm) * cc;
                        } else {
#pragma unroll
                            for (int i = 0; i < 16; ++i) pv[i] -= __builtin_amdgcn_exp2f(sv[i] - mm) * cc;
                        }
                    }
                }
            }
            __builtin_amdgcn_sched_barrier(0);
            if (statpass) continue;
#pragma unroll
            for (int ss = 0; ss < 2; ++ss) {
                const bf16x8 pb = pack8(pv[8 * ss], pv[8 * ss + 1], pv[8 * ss + 2], pv[8 * ss + 3], pv[8 * ss + 4], pv[8 * ss + 5], pv[8 * ss + 6], pv[8 * ss + 7]);
#pragma unroll
                for (int dt = 0; dt < NDT; ++dt) {
                    const LAS unsigned char* vp = Vb + (32 * dt + r) * VP + (32 * sub + 16 * ss + 4 * hh) * 2;
                    const s16x4 lo = *(const LAS s16x4*)vp; const s16x4 hi = *(const LAS s16x4*)(vp + 16);
                    const bf16x8 vf = __builtin_shufflevector(lo, hi, 0, 1, 2, 3, 4, 5, 6, 7);
                    oacc[dt] = MFMA32(vf, pb, oacc[dt]);
                }
            }
        }
    }
    }
#undef LOAD_TILE
#undef WRITE_TILE
    bf16_t* yrow = Y + (rowb + t) * D_MODEL + ycol + 4 * hh;
    if (MODE == 0) {
        float s = 0.f;
#pragma unroll
        for (int dt = 0; dt < NDT; ++dt)
#pragma unroll
            for (int i = 0; i < 16; ++i) s += oacc[dt][i];
        s += __shfl_xor(s, 32);
        const float mean = s * (1.f / 128.f); float q = 0.f;
#pragma unroll
        for (int dt = 0; dt < NDT; ++dt)
#pragma unroll
            for (int i = 0; i < 16; ++i) { const float d = oacc[dt][i] - mean; q += d * d; }
        q += __shfl_xor(q, 32);
        const float rstd = 1.f / sqrtf(q * (1.f / 128.f) + LN_EPS);
        const bf16_t* grow = H + (rowb + t) * pitch + 1536 + hd * 128 + 4 * hh;
#pragma unroll
        for (int dt = 0; dt < NDT; ++dt)
#pragma unroll
            for (int g = 0; g < 4; ++g) {
                const u32x2 gw = *(const u32x2*)(grow + 32 * dt + 8 * g);
                const float g0 = bflo(gw.x), g1 = bfhi(gw.x), g2 = bflo(gw.y), g3 = bfhi(gw.y);
                const float o0 = (oacc[dt][4 * g] - mean) * rstd * (g0 / (1.f + __expf(-g0)));
                const float o1 = (oacc[dt][4 * g + 1] - mean) * rstd * (g1 / (1.f + __expf(-g1)));
                const float o2 = (oacc[dt][4 * g + 2] - mean) * rstd * (g2 / (1.f + __expf(-g2)));
                const float o3 = (oacc[dt][4 * g + 3] - mean) * rstd * (g3 / (1.f + __expf(-g3)));
                u32x2 w; w.x = cvt_pk_bf16(o0, o1); w.y = cvt_pk_bf16(o2, o3);
                *(u32x2*)(yrow + 32 * dt + 8 * g) = w;
            }
    } else if (MODE == 1) {
#pragma unroll
        for (int dt = 0; dt < NDT; ++dt)
#pragma unroll
            for (int g = 0; g < 4; ++g) {
                u32x2 w; w.x = cvt_pk_bf16(oacc[dt][4 * g], oacc[dt][4 * g + 1]); w.y = cvt_pk_bf16(oacc[dt][4 * g + 2], oacc[dt][4 * g + 3]);
                *(u32x2*)(yrow + 32 * dt + 8 * g) = w;
            }
    } else {
        const int li = layer >> 1;
        float q = 0.f;
#pragma unroll
        for (int dt = 0; dt < NDT; ++dt)
#pragma unroll
            for (int i = 0; i < 16; ++i) { const float o = oacc[dt][i]; q += o * o; }
        q += __shfl_xor(q, 32);
        const float rs = (1.f / sqrtf(q * (1.f / 128.f) + LN_EPS)) * (1.f - lam_init);
        const float* sg = a.in[9] + li * 128 + 4 * hh;
#pragma unroll
        for (int dt = 0; dt < NDT; ++dt)
#pragma unroll
            for (int g = 0; g < 4; ++g) {
                const f32x4 gv = *(const f32x4*)(sg + 32 * dt + 8 * g);
                u32x2 w; w.x = cvt_pk_bf16(oacc[dt][4 * g] * rs * gv[0], oacc[dt][4 * g + 1] * rs * gv[1]);
                w.y = cvt_pk_bf16(oacc[dt][4 * g + 2] * rs * gv[2], oacc[dt][4 * g + 3] * rs * gv[3]);
                *(u32x2*)(yrow + 32 * dt + 8 * g) = w;
            }
    }
}

DI void mixer_phase(LAS unsigned char* lds, const Args& a, const int layer) {
    PHASE_IDS;
    const bool even = (layer & 1) == 0;
    const bf16_t* H0 = (const bf16_t*)(a.ws + WS_H); bf16_t* Y0 = (bf16_t*)(a.ws + WS_Y);
    unsigned* ctr = (unsigned*)(a.ws + WS_CTL) + 64 * layer;
    LAS unsigned* qslot = (LAS unsigned*)(lds + 90112);
    const int NU = even ? 1536 : 1024;
    for (;;) {
        __syncthreads();
        if (tid == 0) qslot[0] = atomicAdd(ctr, 1u);
        __syncthreads();
        const int u = (int)qslot[0];
        if (u >= NU) break;
        const bf16_t* H = H0; bf16_t* Y = Y0; OPAQUE(H); OPAQUE(Y);
        if (even) {
            const int qi = u / 192, rem = u - qi * 192, qb = 7 - qi;
            if (rem < 64) attn_unit<0>(lds, a, H, EVEN_IN, Y, rem >> 2, rem & 3, qb, layer);
            else { const int r2 = rem - 64; attn_unit<1>(lds, a, H, EVEN_IN, Y, r2 >> 3, r2 & 7, qb, layer); }
        } else {
            const int qi = u >> 7, rem = u & 127, qb = 7 - qi;
            attn_unit<2>(lds, a, H, ODD_IN, Y, rem >> 3, rem & 7, qb, layer);
        }
    }
}

__global__ void __launch_bounds__(NTHR, 2) fwd_megakernel(Args a) {
    extern __shared__ __attribute__((aligned(16))) unsigned char lds_raw[];
    LAS unsigned char* lds = (LAS unsigned char*)lds_raw;
    cg::grid_group grid = cg::this_grid();
    const int G = gridDim.x, cid = blockIdx.x;
    float* X = a.out;
    bf16_t* XB = (bf16_t*)(a.ws + WS_XB);
    bf16_t* Hb = (bf16_t*)(a.ws + WS_H); bf16_t* Yb = (bf16_t*)(a.ws + WS_Y);
    bf16_t* HUP = (bf16_t*)(a.ws + WS_HUP); bf16_t* Ab = (bf16_t*)(a.ws + WS_A);
    const bf16_t* Win_t = (const bf16_t*)(a.ws + WS_WIN); const bf16_t* Wout_t = (const bf16_t*)(a.ws + WS_WOUT);
    const bf16_t* Wup_t = (const bf16_t*)(a.ws + WS_WUP); const bf16_t* Wdn_t = (const bf16_t*)(a.ws + WS_WDN);

    prologue(a, lds);
    grid.sync();

    for (int l = 0; l < DEPTH; ++l) {
        const bool even = (l & 1) == 0; const int Nin = even ? EVEN_IN : ODD_IN;
        { const bf16_t* pa = XB; const bf16_t* pb = Win_t; bf16_t* po = Hb; OPAQUE(pa); OPAQUE(pb); OPAQUE(po); pg8::Gemm g{pa, pb, MTOK, Nin, D_MODEL}; pg8::StaticOrder S; S.init(MTOK, Nin, G, cid);
          pg8::EpiBf16 E{po, Nin};
          pg8::gemm_phase<pg8::EpiBf16, pg8::StaticOrder, true, true>(lds, g, S, E); }
        grid.sync();
        mixer_phase(lds, a, l);
        grid.sync();
        { const bf16_t* pa = Yb; const bf16_t* pb = Wout_t; float* po = X; OPAQUE(pa); OPAQUE(pb); OPAQUE(po); pg8::Gemm g{pa, pb, MTOK, D_MODEL, D_MODEL}; pg8::StaticOrder S; S.init(MTOK, D_MODEL, G, cid);
          pg8::EpiResid E{po, ALPHA};
          pg8::gemm_phase<pg8::EpiResid, pg8::StaticOrder, true, true>(lds, g, S, E); }
        grid.sync();
        { float* px = X; bf16_t* pxb = XB; const float* pg = a.in[15] + l * D_MODEL; const float* pbt = a.in[16] + l * D_MODEL; OPAQUE(px); OPAQUE(pxb); OPAQUE(pg); OPAQUE(pbt); ln_phase(px, pxb, pg, pbt); }
        grid.sync();
        for (int half = 0; half < 2; ++half) {
            { const bf16_t* pa = XB + (size_t)half * HALF_ROWS * D_MODEL; const bf16_t* pb = Wup_t; bf16_t* po = HUP; OPAQUE(pa); OPAQUE(pb); OPAQUE(po); pg8::Gemm g{pa, pb, HALF_ROWS, FF2, D_MODEL}; pg8::StaticOrder S; S.init(HALF_ROWS, FF2, G, cid);
              pg8::EpiBf16 E{po, FF2};
              pg8::gemm_phase<pg8::EpiBf16, pg8::StaticOrder, true, true>(lds, g, S, E); }
            grid.sync();
            { const bf16_t* ph = HUP; bf16_t* pa2 = Ab; const float* pcw = a.in[12] + (size_t)l * 3 * FF2; const float* pcb = a.in[13] + (size_t)l * FF2; OPAQUE(ph); OPAQUE(pa2); OPAQUE(pcw); OPAQUE(pcb); convgate_phase(ph, pa2, pcw, pcb, half); }
            grid.sync();
        }
        { const bf16_t* pa = Ab; const bf16_t* pb = Wdn_t; float* po = X; OPAQUE(pa); OPAQUE(pb); OPAQUE(po); pg8::Gemm g{pa, pb, MTOK, D_MODEL, D_FF}; pg8::StaticOrder S; S.init(MTOK, D_MODEL, G, cid);
          pg8::EpiResid E{po, ALPHA};
          pg8::gemm_phase<pg8::EpiResid, pg8::StaticOrder, true, true>(lds, g, S, E); }
        grid.sync();
        { float* px = X; bf16_t* pxb = XB; const float* pg = a.in[17] + l * D_MODEL; const float* pbt = a.in[18] + l * D_MODEL; OPAQUE(px); OPAQUE(pxb); OPAQUE(pg); OPAQUE(pbt); ln_phase(px, pxb, pg, pbt); }
        if (l + 1 < DEPTH) convert_weights(a, l + 1, lds);
        grid.sync();
    }
}

extern "C" void kernel_launch(void* const* d_in, const int* in_sizes, int n_in, void* d_out, int out_size, void* d_ws, size_t ws_size, hipStream_t stream) {
    static int grid = 0;
    if (grid == 0) {
        if (n_in != 19 || out_size != MTOK * D_MODEL || ws_size < WS_END) { fprintf(stderr, "kernel_launch: unexpected shapes (n_in %d out %d ws %zu)\n", n_in, out_size, ws_size); grid = -1; return; }
        int dev = 0, cus = 0, per_cu = 0;
        hipGetDevice(&dev);
        hipDeviceGetAttribute(&cus, hipDeviceAttributeMultiprocessorCount, dev);
        if (hipFuncSetAttribute((const void*)fwd_megakernel, hipFuncAttributeMaxDynamicSharedMemorySize, LDS_BYTES) != hipSuccess) { fprintf(stderr, "kernel_launch: hipFuncSetAttribute failed\n"); grid = -1; return; }
        if (hipOccupancyMaxActiveBlocksPerMultiprocessor(&per_cu, (const void*)fwd_megakernel, NTHR, LDS_BYTES) != hipSuccess || per_cu < 1) { fprintf(stderr, "kernel_launch: occupancy query gives %d\n", per_cu); per_cu = 1; }
        (void)hipGetLastError();
        grid = cus * 1;
    }
    if (grid < 0) return;
    Args a{};
    for (int i = 0; i < 19; ++i) a.in[i] = (const float*)d_in[i];
    a.out = (float*)d_out; a.ws = (unsigned char*)d_ws;
    void* args[] = {&a};
    hipError_t e = hipLaunchCooperativeKernel((const void*)fwd_megakernel, dim3(grid), dim3(NTHR), args, LDS_BYTES, stream);
    if (e != hipSuccess) fprintf(stderr, "cooperative launch failed: %s (grid %d)\n", hipGetErrorString(e), grid);
}
```

```cpp
#include <hip/hip_runtime.h>
#include <hip/hip_cooperative_groups.h>
#include <cstdio>
#include <cstdint>
namespace cg = cooperative_groups;
namespace pg8 {
#define PG8_LAS __attribute__((address_space(3)))
typedef unsigned short bf16_t;
typedef short bf16x8 __attribute__((ext_vector_type(8)));
typedef float f32x4 __attribute__((ext_vector_type(4)));
typedef unsigned u32x4 __attribute__((ext_vector_type(4)));
constexpr int BM = 256, BK = 64, HALF = 128, HTB = HALF * BK * 2  , STAGE_BYTES = 8 * HTB, NXCD = 8, WGM = 8;

__host__ __device__ __forceinline__ int lds_byte(int r, int c) { const int st = (r >> 4) * 2 + (c >> 5), rr = r & 15, cc = c & 31, ob = rr * 64 + cc * 2; return st * 1024 + (ob ^ (((ob >> 9) & 1) << 5)); }
__host__ __device__ __forceinline__ void stage_rc(int b, int& R, int& C) { const int st = b / 1024, sb = b % 1024, swz = sb ^ (((sb >> 9) & 1) << 5); R = (st >> 1) * 16 + swz / 64; C = (st & 1) * 32 + (swz % 64) / 2; }
__host__ __device__ __forceinline__ int perm32(int rho) { const int n = rho >> 4, i = rho & 15; return 8 * (i >> 2) + 4 * n + (i & 3); }

struct Unit { int pm, pn; };
struct Gemm { const bf16_t* A; const bf16_t* Bt; int M, N, K; };

struct StaticOrder {
    int nM, nN, nwg, G, c;
    __host__ __device__ void init(int M, int N, int G_, int c_) { nM = M / BM; nN = N / BM; nwg = nM * nN; G = G_; c = c_; }
    __host__ __device__ bool next(int i, Unit& u) const {
        const long L = (long)i * G + c; if (L >= nwg) return false;
        int wgid = (int)L; { const int q = nwg / NXCD, r = nwg % NXCD, xcd = wgid % NXCD, off = wgid / NXCD; wgid = (xcd < r ? xcd * (q + 1) : r * (q + 1) + (xcd - r) * q) + off; }
        const int nig = WGM * nN, gid = wgid / nig, fm = gid * WGM, gsz = (nM - fm) < WGM ? (nM - fm) : WGM;
        u.pm = fm + ((wgid % nig) % gsz); u.pn = (wgid % nig) / gsz; return true;
    }
    __device__ __forceinline__ void a_ready(const Unit&) const {}
    __device__ __forceinline__ void done(const Unit&) const {}
};
__device__ __forceinline__ unsigned cvt_pk_bf16(float lo, float hi) { unsigned r; asm volatile("v_cvt_pk_bf16_f32 %0, %1, %2" : "=v"(r) : "v"(lo), "v"(hi)); return r; }
typedef float f32x2 __attribute__((ext_vector_type(2)));
struct EpiBf16 {
    static constexpr bool PERM = true, AFTER_DRAIN = false;
    bf16_t* O; int ldc;
    __device__ __forceinline__ void operator()(const f32x4 (&acc)[2][2][4][2], const Unit& u, int wr, int wc, int fr, int fq) const {
        const int row0 = u.pm * BM + wr * 64 + fr; const int col0 = u.pn * BM + wc * 32 + 8 * fq;
#pragma unroll
        for (int ai = 0; ai < 2; ++ai)
#pragma unroll
            for (int m = 0; m < 4; ++m) { bf16_t* rowp = O + (size_t)(row0 + ai * HALF + m * 16) * ldc + col0;
#pragma unroll
                for (int bj = 0; bj < 2; ++bj) { const f32x4 v0 = acc[ai][bj][m][0], v1 = acc[ai][bj][m][1];
                    u32x4 w; w.x = cvt_pk_bf16(v0[0], v0[1]); w.y = cvt_pk_bf16(v0[2], v0[3]); w.z = cvt_pk_bf16(v1[0], v1[1]); w.w = cvt_pk_bf16(v1[2], v1[3]);
                    *(u32x4*)(rowp + bj * HALF) = w; } }
    }
};
struct EpiResid {
    static constexpr bool PERM = false, AFTER_DRAIN = false;
    float* X; float alpha;
    __device__ __forceinline__ void operator()(const f32x4 (&acc)[2][2][4][2], const Unit& u, int wr, int wc, int fr, int fq) const {
        float* p = X + (size_t)(u.pm * BM + wr * 64 + fr) * 1024 + u.pn * BM + wc * 32 + 4 * fq;
#pragma unroll
        for (int ai = 0; ai < 2; ++ai)
#pragma unroll
            for (int m = 0; m < 4; ++m) { float* q = p + (ai * HALF + m * 16) * 1024;
                asm volatile("" : "+v"(q));
#pragma unroll
                for (int bj = 0; bj < 2; ++bj)
#pragma unroll
                    for (int n = 0; n < 2; ++n) { const f32x4 x = *(const f32x4*)(q + bj * HALF + n * 16);
                        *(f32x4*)(q + bj * HALF + n * 16) = acc[ai][bj][m][n] + alpha * x; }
                asm volatile("" ::: "memory"); }
    }
};
template <class Epi, class Sched, bool ALIGN_EPI = false, bool SP2 = false>
__device__ __forceinline__ void gemm_phase(PG8_LAS unsigned char* lds, const Gemm g, const Sched& S, const Epi& E) {
    int tid = threadIdx.x; asm volatile("" : "+v"(tid));
    const int wid = __builtin_amdgcn_readfirstlane(tid >> 6), lane = tid & 63, wr = wid >> 2, wc = wid & 3, fr = lane & 15, fq = lane >> 4;
    const int K = g.K, nt = K / BK;
    unsigned voffA[2], voffB[2];
#pragma unroll
    for (int i = 0; i < 2; ++i) { int R, C; stage_rc(tid * 16 + i * 8192, R, C); const int Rb = Epi::PERM ? ((R & ~31) + perm32(R & 31)) : R;
        voffA[i] = (unsigned)(R * K + C) * 2u; voffB[i] = (unsigned)(Rb * K + C) * 2u; }
    const size_t kstep = (size_t)(BK * 2);
    const size_t hstep = (size_t)HALF * K * 2;
    const size_t tstep = 2 * hstep;
    const unsigned ldsw = (unsigned)wid * 1024u;
    const int aoff = lds_byte(wr * 64 + fr, fq * 8), boff = lds_byte(wc * 32 + fr, fq * 8);
#define PG8_SA(b, h) (((b) * 2 + (h)) * HTB)
#define PG8_SB(b, h) ((4 + (b) * 2 + (h)) * HTB)
#define PG8_STAGE(bufoff, gbase, voff) do { _Pragma("unroll") for (int _i = 0; _i < 2; ++_i) \
        __builtin_amdgcn_global_load_lds((const unsigned*)((const char*)(gbase) + (voff)[_i]), (PG8_LAS unsigned*)(lds + (bufoff) + ldsw + _i * 8192), 16, 0, 0); } while (0)
#define PG8_LDA(dst, b, h) do { _Pragma("unroll") for (int m = 0; m < 4; ++m) _Pragma("unroll") for (int k = 0; k < 2; ++k) dst[m][k] = *(const PG8_LAS bf16x8*)(lds + PG8_SA(b, h) + aoff + m * 2048 + k * 1024); } while (0)
#define PG8_LDB(dst, b, h) do { _Pragma("unroll") for (int n = 0; n < 2; ++n) _Pragma("unroll") for (int k = 0; k < 2; ++k) dst[n][k] = *(const PG8_LAS bf16x8*)(lds + PG8_SB(b, h) + boff + n * 2048 + k * 1024); } while (0)
#define PG8_MMA(ai, bj, At, Bt) do { __builtin_amdgcn_s_setprio(1); _Pragma("unroll") for (int m = 0; m < 4; ++m) _Pragma("unroll") for (int n = 0; n < 2; ++n) _Pragma("unroll") for (int k = 0; k < 2; ++k) \
        acc[ai][bj][m][n] = __builtin_amdgcn_mfma_f32_16x16x32_bf16(Bt[n][k], At[m][k], acc[ai][bj][m][n], 0, 0, 0); __builtin_amdgcn_s_setprio(0); } while (0)
#define PG8_WAIT_V(n) asm volatile("s_waitcnt vmcnt(" #n ")" ::: "memory")
#define PG8_WAIT_L(n) asm volatile("s_waitcnt lgkmcnt(" #n ")" ::: "memory")
#define PG8_BAR __builtin_amdgcn_s_barrier()
#define PG8_SCHED __builtin_amdgcn_sched_barrier(0)
    Unit cur, nxt; int ui = 0;
    if (!S.next(0, cur)) return;
    f32x4 acc[2][2][4][2];
#pragma unroll
    for (int a = 0; a < 2; ++a)
#pragma unroll
        for (int b = 0; b < 2; ++b)
#pragma unroll
            for (int m = 0; m < 4; ++m)
#pragma unroll
                for (int n = 0; n < 2; ++n) acc[a][b][m][n] = (f32x4){0.f, 0.f, 0.f, 0.f};
    bf16x8 At[4][2], B0[2][2], B1[2][2];
    const char* cA = (const char*)g.A + (size_t)cur.pm * tstep; const char* cB = (const char*)g.Bt + (size_t)cur.pn * tstep;
    S.a_ready(cur);
    if constexpr (SP2) {
        PG8_STAGE(PG8_SB(0, 0), cB, voffB); PG8_STAGE(PG8_SB(0, 1), cB + hstep, voffB); PG8_STAGE(PG8_SA(0, 0), cA, voffA); PG8_STAGE(PG8_SA(0, 1), cA + hstep, voffA);
        if (wr == 1) PG8_BAR;
        PG8_WAIT_V(2); PG8_BAR;
        PG8_STAGE(PG8_SB(1, 0), cB + kstep, voffB); PG8_STAGE(PG8_SA(1, 0), cA + kstep, voffA); PG8_STAGE(PG8_SB(1, 1), cB + hstep + kstep, voffB);
        PG8_WAIT_V(6); PG8_BAR;
    } else {
        PG8_STAGE(PG8_SB(0, 0), cB, voffB); PG8_STAGE(PG8_SA(0, 0), cA, voffA); PG8_STAGE(PG8_SB(0, 1), cB + hstep, voffB); PG8_STAGE(PG8_SA(0, 1), cA + hstep, voffA);
        if (wr == 1) PG8_BAR;
        PG8_WAIT_V(4); PG8_BAR;
        PG8_STAGE(PG8_SB(1, 0), cB + kstep, voffB); PG8_STAGE(PG8_SA(1, 0), cA + kstep, voffA); PG8_STAGE(PG8_SB(1, 1), cB + hstep + kstep, voffB);
        PG8_WAIT_V(6); PG8_BAR;
    }
    for (;;) {
        const bool has_next = S.next(ui + 1, nxt);
        const char* nA = has_next ? (const char*)g.A + (size_t)nxt.pm * tstep : cA; const char* nB = has_next ? (const char*)g.Bt + (size_t)nxt.pn * tstep : cB;
        for (int t = 0; t < nt; t += 2) {
            const bool last = (t == nt - 2);
            const char* a1 = cA + (size_t)(t + 1) * kstep;
            const char* a2 = last ? nA : cA + (size_t)(t + 2) * kstep; const char* b2 = last ? nB : cB + (size_t)(t + 2) * kstep;
            const char* a3 = a2 + kstep; const char* b3 = b2 + kstep;
            if (last && has_next) S.a_ready(nxt);
            if constexpr (SP2) {
            PG8_LDB(B0, 0, 0); PG8_LDB(B1, 0, 1); PG8_SCHED; PG8_LDA(At, 0, 0); PG8_STAGE(PG8_SA(1, 1), a1 + hstep, voffA);
            PG8_WAIT_V(8); PG8_WAIT_L(0); PG8_BAR; PG8_MMA(0, 0, At, B0); PG8_MMA(0, 1, At, B1); PG8_BAR; PG8_SCHED;
            PG8_LDA(At, 0, 1); PG8_STAGE(PG8_SB(0, 0), b2, voffB); PG8_STAGE(PG8_SB(0, 1), b2 + hstep, voffB); PG8_STAGE(PG8_SA(0, 0), a2, voffA);
            PG8_WAIT_V(8); PG8_WAIT_L(0); PG8_BAR; PG8_MMA(1, 0, At, B0); PG8_MMA(1, 1, At, B1); PG8_BAR; PG8_SCHED;
            PG8_LDB(B0, 1, 0); PG8_LDB(B1, 1, 1); PG8_SCHED; PG8_LDA(At, 1, 0); PG8_STAGE(PG8_SA(0, 1), a2 + hstep, voffA);
            PG8_WAIT_V(8); PG8_WAIT_L(0); PG8_BAR; PG8_MMA(0, 0, At, B0); PG8_MMA(0, 1, At, B1); PG8_BAR; PG8_SCHED;
            PG8_LDA(At, 1, 1); PG8_STAGE(PG8_SB(1, 0), b3, voffB); PG8_STAGE(PG8_SB(1, 1), b3 + hstep, voffB); PG8_STAGE(PG8_SA(1, 0), a3, voffA);
            PG8_WAIT_V(8); PG8_WAIT_L(0); PG8_BAR; PG8_MMA(1, 0, At, B0); PG8_MMA(1, 1, At, B1); PG8_BAR; PG8_SCHED;
            } else {
            PG8_LDB(B0, 0, 0); PG8_SCHED; PG8_LDA(At, 0, 0); PG8_STAGE(PG8_SA(1, 1), a1 + hstep, voffA);
            PG8_WAIT_L(8); PG8_BAR; PG8_WAIT_L(0); PG8_MMA(0, 0, At, B0); PG8_BAR; PG8_SCHED;
            PG8_LDB(B1, 0, 1); PG8_STAGE(PG8_SB(0, 0), b2, voffB);
            PG8_BAR; PG8_WAIT_L(0); PG8_MMA(0, 1, At, B1); PG8_BAR;
            PG8_LDA(At, 0, 1); PG8_STAGE(PG8_SA(0, 0), a2, voffA);
            PG8_BAR; PG8_WAIT_L(0); PG8_MMA(1, 0, At, B0); PG8_BAR; PG8_SCHED;
            PG8_STAGE(PG8_SB(0, 1), b2 + hstep, voffB);
            PG8_WAIT_V(6); PG8_BAR; PG8_MMA(1, 1, At, B1); PG8_BAR;
            PG8_LDB(B0, 1, 0); PG8_SCHED; PG8_LDA(At, 1, 0); PG8_STAGE(PG8_SA(0, 1), a2 + hstep, voffA);
            PG8_WAIT_L(8); PG8_BAR; PG8_WAIT_L(0); PG8_MMA(0, 0, At, B0); PG8_BAR; PG8_SCHED;
            PG8_LDB(B1, 1, 1); PG8_STAGE(PG8_SB(1, 0), b3, voffB);
            PG8_BAR; PG8_WAIT_L(0); PG8_MMA(0, 1, At, B1); PG8_BAR;
            PG8_LDA(At, 1, 1); PG8_STAGE(PG8_SA(1, 0), a3, voffA);
            PG8_BAR; PG8_WAIT_L(0); PG8_MMA(1, 0, At, B0); PG8_BAR; PG8_SCHED;
            PG8_STAGE(PG8_SB(1, 1), b3 + hstep, voffB);
            PG8_WAIT_V(6); PG8_BAR; PG8_MMA(1, 1, At, B1); PG8_BAR;
            }
        }
        if constexpr (ALIGN_EPI) { if (wr == 0) PG8_BAR; }
        if constexpr (!Epi::AFTER_DRAIN) { E(acc, cur, wr, wc, fr, fq); S.done(cur); }
        if (!has_next) break;
#pragma unroll
        for (int a = 0; a < 2; ++a)
#pragma unroll
            for (int b = 0; b < 2; ++b)
#pragma unroll
                for (int m = 0; m < 4; ++m)
#pragma unroll
                    for (int n = 0; n < 2; ++n) acc[a][b][m][n] = (f32x4){0.f, 0.f, 0.f, 0.f};
        cur = nxt; cA = nA; cB = nB; ++ui;
        if constexpr (ALIGN_EPI) { if (wr == 1) PG8_BAR; }
    }
    PG8_WAIT_V(0);
    if constexpr (!ALIGN_EPI) { if (wr == 0) PG8_BAR; }
    PG8_BAR;
    if constexpr (Epi::AFTER_DRAIN) { E.fused(acc, cur, wr, wc, fr, fq, lds, wid, lane); S.done(cur); }
#undef PG8_SA
#undef PG8_SB
#undef PG8_STAGE
#undef PG8_LDA
#undef PG8_LDB
#undef PG8_MMA
#undef PG8_WAIT_V
#undef PG8_WAIT_L
#undef PG8_BAR
#undef PG8_SCHED
}
}

#define DI __device__ __forceinline__
#define LAS __attribute__((address_space(3)))
using pg8::bf16_t; using pg8::bf16x8; using pg8::f32x4; using pg8::u32x4; using pg8::cvt_pk_bf16;
typedef short s16x4 __attribute__((ext_vector_type(4)));
typedef float f32x16 __attribute__((ext_vector_type(16)));
typedef unsigned u32x2 __attribute__((ext_vector_type(2)));

constexpr int D_MODEL = 1024, BATCH = 16, SEQ = 2048, DEPTH = 4, MTOK = BATCH * SEQ;
constexpr int D_FF = 2816, FF2 = 2 * D_FF, EVEN_IN = 3584, ODD_IN = 3072;
constexpr float ALPHA = 1.681792830507f, LN_EPS = 1e-5f, LOG2E = 1.4426950408889634f;
constexpr int NWAVES = 8, NTHR = 512;
constexpr int LDS_BYTES = 147456;
constexpr int HALF_ROWS = MTOK / 2;

constexpr size_t MiB = 1u << 20;
constexpr size_t WS_CTL = 0, WS_ROPE = 1 * MiB, WS_WIN = 2 * MiB, WS_WOUT = 10 * MiB, WS_WUP = 12 * MiB, WS_WDN = 24 * MiB;
constexpr size_t WS_XB = 32 * MiB, WS_H = 96 * MiB, WS_Y = 320 * MiB, WS_HUP = 96 * MiB, WS_A = 272 * MiB, WS_END = 448 * MiB;

__device__ const float ROPE_INV[64] = {
1.000000000e+00f, 8.659643531e-01f, 7.498942614e-01f, 6.493816376e-01f, 5.623413324e-01f, 4.869675338e-01f, 4.216965139e-01f, 3.651741147e-01f, 3.162277639e-01f, 2.738419771e-01f, 2.371373773e-01f, 2.053525001e-01f, 1.778279394e-01f, 1.539926529e-01f, 1.333521307e-01f, 1.154782027e-01f, 1.000000015e-01f, 8.659642935e-02f, 7.498941571e-02f, 6.493816525e-02f, 5.623413250e-02f, 4.869675264e-02f, 4.216965288e-02f, 3.651741147e-02f, 3.162277490e-02f, 2.738419734e-02f, 2.371373773e-02f, 2.053525113e-02f, 1.778279431e-02f, 1.539926510e-02f, 1.333521493e-02f, 1.154782064e-02f, 9.999999776e-03f, 8.659643121e-03f, 7.498941850e-03f, 6.493816152e-03f, 5.623413250e-03f, 4.869675264e-03f, 4.216964822e-03f, 3.651741194e-03f, 3.162277630e-03f, 2.738419687e-03f, 2.371373586e-03f, 2.053524833e-03f, 1.778279431e-03f, 1.539926510e-03f, 1.333521446e-03f, 1.154781901e-03f, 1.000000047e-03f, 8.659643354e-04f, 7.498942432e-04f, 6.493816618e-04f, 5.623413017e-04f, 4.869675322e-04f, 4.216965172e-04f, 3.651741426e-04f, 3.162277571e-04f, 2.738419571e-04f, 2.371373703e-04f, 2.053525095e-04f, 1.778279402e-04f, 1.539926452e-04f, 1.333521504e-04f, 1.154782003e-04f };
__device__ const unsigned char T5B[129] = {
0, 1, 2, 3, 4, 5, 6, 7, 8, 9, 10, 11, 12, 13, 14, 15, 16, 16, 16, 17, 17, 18, 18, 18, 19, 19, 19, 20, 20, 20, 20, 21, 21, 21, 21, 22, 22, 22, 22, 22, 23, 23, 23, 23, 23, 23, 24, 24, 24, 24, 24, 24, 25, 25, 25, 25, 25, 25, 25, 26, 26, 26, 26, 26, 26, 26, 26, 27, 27, 27, 27, 27, 27, 27, 27, 27, 27, 28, 28, 28, 28, 28, 28, 28, 28, 28, 28, 29, 29, 29, 29, 29, 29, 29, 29, 29, 29, 29, 29, 30, 30, 30, 30, 30, 30, 30, 30, 30, 30, 30, 30, 30, 30, 31, 31, 31, 31, 31, 31, 31, 31, 31, 31, 31, 31, 31, 31, 31, 31 };

struct Args { const float* in[19]; float* out; unsigned char* ws; };
#define OPAQUE(p) asm volatile("" : "+s"(p))
#define PHASE_IDS int tid = threadIdx.x; asm volatile("" : "+v"(tid)); const int lane = tid & 63, wid = __builtin_amdgcn_readfirstlane(tid >> 6); (void)lane; (void)wid

DI float bflo(unsigned w) { return __uint_as_float(w << 16); }
DI float bfhi(unsigned w) { return __uint_as_float(w & 0xffff0000u); }
DI float wave_sum(float v) {
#pragma unroll
    for (int o = 1; o < 64; o <<= 1) v += __shfl_xor(v, o);
    return v;
}
DI unsigned f2bf(float f) { unsigned u = __float_as_uint(f); return (u + 0x7fffu + ((u >> 16) & 1u)) >> 16; }
DI unsigned pk2(float lo, float hi) { return f2bf(lo) | (f2bf(hi) << 16); }

DI void transpose_item(const float* W, int K, int N, bf16_t* WT, LAS float* scr, int item, int lane) {
    const int nblk = N / 32, kb = item / nblk, nb = item % nblk, k0 = 64 * kb, n0 = 32 * nb;
#pragma unroll 8
    for (int i = 0; i < 32; ++i) { const int kk = 2 * i + (lane >> 5); scr[kk * 33 + (lane & 31)] = W[(size_t)(k0 + kk) * N + n0 + (lane & 31)]; }
    asm volatile("s_waitcnt lgkmcnt(0)" ::: "memory");
    const int c = lane & 7;
#pragma unroll
    for (int j = 0; j < 4; ++j) { const int n = (lane >> 3) + 8 * j; const LAS float* s = scr + (8 * c) * 33 + n;
        u32x4 o; o.x = pk2(s[0 * 33], s[1 * 33]); o.y = pk2(s[2 * 33], s[3 * 33]); o.z = pk2(s[4 * 33], s[5 * 33]); o.w = pk2(s[6 * 33], s[7 * 33]);
        *(u32x4*)(WT + (size_t)(n0 + n) * K + k0 + 8 * c) = o; }
    asm volatile("s_waitcnt lgkmcnt(0)" ::: "memory");
}
DI void convert_weights(const Args& a, int l, LAS unsigned char* lds) {
    PHASE_IDS;
    LAS float* scr = (LAS float*)(lds + wid * 16384);
    const int gw = blockIdx.x * NWAVES + wid, NGW = gridDim.x * NWAVES;
    const int li = l >> 1; const bool even = (l & 1) == 0;
    const int Nin = even ? EVEN_IN : ODD_IN;
    const float* Win = even ? a.in[1] + (size_t)li * D_MODEL * EVEN_IN : a.in[3] + (size_t)li * D_MODEL * ODD_IN;
    const float* Wout = (even ? a.in[2] : a.in[4]) + (size_t)li * D_MODEL * D_MODEL;
    const float* Wup = a.in[11] + (size_t)l * D_MODEL * FF2;
    const float* Wdn = a.in[14] + (size_t)l * D_FF * D_MODEL;
    bf16_t* Win_t = (bf16_t*)(a.ws + WS_WIN); bf16_t* Wout_t = (bf16_t*)(a.ws + WS_WOUT); bf16_t* Wup_t = (bf16_t*)(a.ws + WS_WUP); bf16_t* Wdn_t = (bf16_t*)(a.ws + WS_WDN);
    const int I_in = (D_MODEL / 64) * (Nin / 32), I_out = (D_MODEL / 64) * (D_MODEL / 32), I_up = (D_MODEL / 64) * (FF2 / 32), I_dn = (D_FF / 64) * (D_MODEL / 32);
    const int NIT = I_in + I_out + I_up + I_dn;
    for (int it = gw; it < NIT; it += NGW) {
        int r = it;
        if (r < I_in) { transpose_item(Win, D_MODEL, Nin, Win_t, scr, r, lane); continue; } r -= I_in;
        if (r < I_out) { transpose_item(Wout, D_MODEL, D_MODEL, Wout_t, scr, r, lane); continue; } r -= I_out;
        if (r < I_up) { transpose_item(Wup, D_MODEL, FF2, Wup_t, scr, r, lane); continue; } r -= I_up;
        transpose_item(Wdn, D_FF, D_MODEL, Wdn_t, scr, r, lane);
    }
}
DI void prologue(const Args& a, LAS unsigned char* lds) {
    PHASE_IDS;
    if (blockIdx.x == 0 && tid < 64) ((unsigned*)(a.ws + WS_CTL))[tid * 64] = 0u;
    convert_weights(a, 0, lds);
    { const f32x4* x4 = (const f32x4*)a.in[0]; u32x2* o = (u32x2*)(a.ws + WS_XB);
      const size_t n4 = (size_t)MTOK * D_MODEL / 4;
      for (size_t i = (size_t)blockIdx.x * NTHR + tid; i < n4; i += (size_t)gridDim.x * NTHR) { const f32x4 v = x4[i]; u32x2 w; w.x = cvt_pk_bf16(v[0], v[1]); w.y = cvt_pk_bf16(v[2], v[3]); o[i] = w; ((f32x4*)a.out)[i] = v; } }
    { float* rp = (float*)(a.ws + WS_ROPE);
      for (int i = blockIdx.x * NTHR + tid; i < SEQ * 64; i += gridDim.x * NTHR) {
          const int pos = i >> 6, fi = i & 63;
          const float ang = (float)pos * ROPE_INV[fi];
          const double rev = (double)ang * 0.15915494309189535; const double fr = rev - __builtin_rint(rev);
          const float f = (float)fr;
          rp[2 * i] = __builtin_amdgcn_cosf(f); rp[2 * i + 1] = __builtin_amdgcn_sinf(f); } }
}

DI void ln_phase(float* X, bf16_t* XB, const float* g, const float* bt) {
    PHASE_IDS;
    const int gw = blockIdx.x * NWAVES + wid, NGW = gridDim.x * NWAVES;
    f32x4 gg[4], bb[4];
#pragma unroll
    for (int j = 0; j < 4; ++j) { gg[j] = ((const f32x4*)g)[lane + 64 * j]; bb[j] = ((const f32x4*)bt)[lane + 64 * j]; }
    for (int row = gw; row < MTOK; row += NGW) {
        f32x4* xr = (f32x4*)(X + (size_t)row * D_MODEL) + lane;
        f32x4 v[4]; float s = 0.f;
#pragma unroll
        for (int j = 0; j < 4; ++j) { v[j] = xr[64 * j]; s += (v[j][0] + v[j][1]) + (v[j][2] + v[j][3]); }
        const float mean = wave_sum(s) * (1.f / D_MODEL); float s2 = 0.f;
#pragma unroll
        for (int j = 0; j < 4; ++j) { v[j] = v[j] - mean; s2 += (v[j][0] * v[j][0] + v[j][1] * v[j][1]) + (v[j][2] * v[j][2] + v[j][3] * v[j][3]); }
        const float rstd = 1.f / sqrtf(wave_sum(s2) * (1.f / D_MODEL) + LN_EPS);
        u32x2* o8 = (u32x2*)(XB + (size_t)row * D_MODEL) + lane;
#pragma unroll
        for (int j = 0; j < 4; ++j) { const f32x4 o = v[j] * rstd * gg[j] + bb[j]; xr[64 * j] = o;
            u32x2 w; w.x = cvt_pk_bf16(o[0], o[1]); w.y = cvt_pk_bf16(o[2], o[3]); o8[64 * j] = w; }
    }
}

DI void conv8(const u32x4 h0, const u32x4 h1, const u32x4 h2, const float* cw, const float* cb, float (&o)[8]) {
    float w0[8], w1[8], w2[8], bb[8];
#pragma unroll
    for (int q = 0; q < 2; ++q) {
        const f32x4 a0 = *(const f32x4*)(cw + 4 * q), a1 = *(const f32x4*)(cw + FF2 + 4 * q), a2 = *(const f32x4*)(cw + 2 * FF2 + 4 * q), ab = *(const f32x4*)(cb + 4 * q);
#pragma unroll
        for (int e = 0; e < 4; ++e) { w0[4 * q + e] = a0[e]; w1[4 * q + e] = a1[e]; w2[4 * q + e] = a2[e]; bb[4 * q + e] = ab[e]; }
    }
#pragma unroll
    for (int k = 0; k < 4; ++k) {
        o[2 * k] = w2[2 * k] * bflo(h0[k]) + w1[2 * k] * bflo(h1[k]) + w0[2 * k] * bflo(h2[k]) + bb[2 * k];
        o[2 * k + 1] = w2[2 * k + 1] * bfhi(h0[k]) + w1[2 * k + 1] * bfhi(h1[k]) + w0[2 * k + 1] * bfhi(h2[k]) + bb[2 * k + 1];
    }
}
DI void convgate_phase(const bf16_t* HUP, bf16_t* A, const float* cw, const float* cb, int half) {
    PHASE_IDS;
    constexpr int NCH = D_FF / 8;
    const int total = HALF_ROWS * NCH;
    for (int idx = blockIdx.x * NTHR + tid; idx < total; idx += gridDim.x * NTHR) {
        const int rl = idx / NCH, ch = idx - rl * NCH, c = ch * 8, tin = rl & (SEQ - 1);
        const bf16_t* hp = HUP + (size_t)rl * FF2 + c;
        const u32x4 z = {0u, 0u, 0u, 0u};
        const u32x4 u0 = *(const u32x4*)hp, g0 = *(const u32x4*)(hp + D_FF);
        const u32x4 u1 = tin >= 1 ? *(const u32x4*)(hp - FF2) : z, g1 = tin >= 1 ? *(const u32x4*)(hp - FF2 + D_FF) : z;
        const u32x4 u2 = tin >= 2 ? *(const u32x4*)(hp - 2 * FF2) : z, g2 = tin >= 2 ? *(const u32x4*)(hp - 2 * FF2 + D_FF) : z;
        float uo[8], go[8];
        conv8(u0, u1, u2, cw + c, cb + c, uo);
        conv8(g0, g1, g2, cw + D_FF + c, cb + D_FF + c, go);
        float r[8];
#pragma unroll
        for (int j = 0; j < 8; ++j) { const float gv = go[j]; r[j] = gv / (1.f + __expf(-gv)) * uo[j]; }
        u32x4 w; w.x = cvt_pk_bf16(r[0], r[1]); w.y = cvt_pk_bf16(r[2], r[3]); w.z = cvt_pk_bf16(r[4], r[5]); w.w = cvt_pk_bf16(r[6], r[7]);
        *(u32x4*)(A + ((size_t)half * HALF_ROWS + rl) * D_FF + c) = w;
    }
}

#define MFMA32(a, b, c) __builtin_amdgcn_mfma_f32_32x32x16_bf16((a), (b), (c), 0, 0, 0)
DI bf16x8 pack8(float f0, float f1, float f2, float f3, float f4, float f5, float f6, float f7) {
    u32x4 p; p.x = cvt_pk_bf16(f0, f1); p.y = cvt_pk_bf16(f2, f3); p.z = cvt_pk_bf16(f4, f5); p.w = cvt_pk_bf16(f6, f7);
    return __builtin_bit_cast(bf16x8, p);
}
DI void rot8(u32x4& a, u32x4& b, const float* tab) {
    const f32x4 t0 = *(const f32x4*)tab, t1 = *(const f32x4*)(tab + 4), t2 = *(const f32x4*)(tab + 8), t3 = *(const f32x4*)(tab + 12);
    float o1[8], o2[8];
#pragma unroll
    for (int k = 0; k < 4; ++k) {
        const f32x4 tt = k == 0 ? t0 : (k == 1 ? t1 : (k == 2 ? t2 : t3));
        const float x1l = bflo(a[k]), x1h = bfhi(a[k]), x2l = bflo(b[k]), x2h = bfhi(b[k]);
        o1[2 * k] = x1l * tt[0] - x2l * tt[1]; o2[2 * k] = x1l * tt[1] + x2l * tt[0];
        o1[2 * k + 1] = x1h * tt[2] - x2h * tt[3]; o2[2 * k + 1] = x1h * tt[3] + x2h * tt[2];
    }
    a.x = cvt_pk_bf16(o1[0], o1[1]); a.y = cvt_pk_bf16(o1[2], o1[3]); a.z = cvt_pk_bf16(o1[4], o1[5]); a.w = cvt_pk_bf16(o1[6], o1[7]);
    b.x = cvt_pk_bf16(o2[0], o2[1]); b.y = cvt_pk_bf16(o2[2], o2[3]); b.z = cvt_pk_bf16(o2[4], o2[5]); b.w = cvt_pk_bf16(o2[6], o2[7]);
}

template <int MODE>
DI void attn_unit(LAS unsigned char* lds, const Args& a, const bf16_t* __restrict__ H, const int pitch, bf16_t* __restrict__ Y,
                  const int b, const int hd, const int qb, const int layer) {
    constexpr int KD = (MODE == 1) ? 64 : 128, DV = (MODE == 1) ? 64 : 128, NQS = KD / 16, NDT = DV / 32, NMAP = (MODE == 2) ? 2 : 1;
    constexpr int KP = KD * 2 + 16, VP = 64 * 2 + 8, BUFB = 36864, VOFF = 18432;
    int tid = threadIdx.x; asm volatile("" : "+v"(tid));
    const int lane = tid & 63, wid = __builtin_amdgcn_readfirstlane(tid >> 6), r = lane & 31, hh = lane >> 5;
    int qcol, kcol, vcol, ycol;
    if (MODE == 0) { qcol = hd * 128; kcol = 512 + hd * 128; vcol = 1024 + hd * 128; ycol = hd * 128; }
    else if (MODE == 1) { qcol = 2048 + hd * 64; kcol = 2560 + hd * 64; vcol = 3072 + hd * 64; ycol = 512 + hd * 64; }
    else { qcol = hd * 128; kcol = 1024 + hd * 128; vcol = 2048 + hd * 128; ycol = hd * 128; }
    const size_t rowb = (size_t)b * SEQ;
    const int t0 = qb * 256 + wid * 32, t = t0 + r;
    const float* rope = (const float*)(a.ws + WS_ROPE);
    LAS float* biasT = (LAS float*)(lds + 81920);
    if (MODE == 2) { if (tid < 129) biasT[tid] = a.in[10][(int)T5B[tid] * 8 + hd] * LOG2E; }

    u32x4 qf[NQS];
    { const bf16_t* qp = H + (rowb + t) * pitch + qcol + 8 * hh;
#pragma unroll
      for (int st = 0; st < NQS; ++st) qf[st] = *(const u32x4*)(qp + 16 * st); }
    if (MODE == 0) {
#pragma unroll
        for (int st = 0; st < 4; ++st) rot8(qf[st], qf[st + 4], rope + ((size_t)t * 64 + 16 * st + 8 * hh) * 2);
    }
    const int ks = tid >> 3, kc = tid & 7;
    const bf16_t* kg = H + (rowb + ks) * pitch + kcol + 8 * kc;
    const int vdb = (DV == 128) ? 16 * wid : 8 * wid;
    const bf16_t* vg = H + (rowb + lane) * pitch + vcol + vdb;
    u32x4 kr0, kr1, vr0, vr1;
    kr1 = (u32x4){0u, 0u, 0u, 0u}; vr1 = kr1;
#define LOAD_TILE(kt) do { const size_t off_ = (size_t)(kt) * 64 * pitch; kr0 = *(const u32x4*)(kg + off_); if (KD == 128) kr1 = *(const u32x4*)(kg + off_ + 64); \
        vr0 = *(const u32x4*)(vg + off_); if (DV == 128) vr1 = *(const u32x4*)(vg + off_ + 8); } while (0)
#define WRITE_TILE(kt, buf) do { LAS unsigned char* Kb_ = lds + (buf) * BUFB; LAS unsigned char* Vb_ = Kb_ + VOFF; \
        if (MODE == 0) rot8(kr0, kr1, rope + ((size_t)((kt) * 64 + ks) * 64 + 8 * kc) * 2); \
        *(LAS u32x4*)(Kb_ + ks * KP + kc * 16) = kr0; if (KD == 128) *(LAS u32x4*)(Kb_ + ks * KP + 128 + kc * 16) = kr1; \
        _Pragma("unroll") for (int i_ = 0; i_ < 4; ++i_) { \
            *(LAS unsigned short*)(Vb_ + (vdb + 2 * i_) * VP + lane * 2) = (unsigned short)(vr0[i_] & 0xffffu); \
            *(LAS unsigned short*)(Vb_ + (vdb + 2 * i_ + 1) * VP + lane * 2) = (unsigned short)(vr0[i_] >> 16); \
            if (DV == 128) { *(LAS unsigned short*)(Vb_ + (vdb + 8 + 2 * i_) * VP + lane * 2) = (unsigned short)(vr1[i_] & 0xffffu); \
                             *(LAS unsigned short*)(Vb_ + (vdb + 8 + 2 * i_ + 1) * VP + lane * 2) = (unsigned short)(vr1[i_] >> 16); } } } while (0)

    f32x16 oacc[NDT];
#pragma unroll
    for (int dt = 0; dt < NDT; ++dt)
#pragma unroll
        for (int i = 0; i < 16; ++i) oacc[dt][i] = 0.f;
    float mrun[NMAP], lrun[NMAP], cmul[NMAP];
#pragma unroll
    for (int p = 0; p < NMAP; ++p) { mrun[p] = -INFINITY; lrun[p] = 0.f; cmul[p] = 0.f; }
    float Rrun = 0.f;
    const float lg2 = (MODE == 0) ? (hd == 0 ? -4.580368961312e-02f : (hd == 1 ? -2.272007650008e-02f : (hd == 2 ? -1.131531322783e-02f : -5.646563141142e-03f))) : 0.f;
    const float lam_init = (layer == 1) ? 0.3555090676f : 0.5560582042f;

    const int nkt = qb * 4 + 4;
    constexpr int NPASS = (MODE == 2) ? 2 : 1;
    for (int pass = 0; pass < NPASS; ++pass) {
    const bool statpass = (MODE == 2) && (pass == 0);
    if (MODE == 2 && pass == 1) {
        const int li = layer >> 1;
        const float d1 = wave_sum(a.in[5][li * 64 + lane] * a.in[6][li * 64 + lane]);
        const float d2 = wave_sum(a.in[7][li * 64 + lane] * a.in[8][li * 64 + lane]);
        const float lam = expf(d1) - expf(d2) + lam_init;
        cmul[0] = 1.f / lrun[0]; cmul[NMAP - 1] = lam / lrun[NMAP - 1];
    }
    if (MODE != 2) LOAD_TILE(nkt - 1);
    LAS unsigned* dflag = (LAS unsigned*)(lds + 90112 + 64);
    for (int it = 0; it < nkt; ++it) {
        const int kt = nkt - 1 - it, buf = it & 1;
        if (MODE == 2) LOAD_TILE(kt);
        WRITE_TILE(kt, buf);
        __syncthreads();
        if (MODE == 1 && it > 0) {
            const LAS unsigned* df = dflag + ((it - 1) & 1) * 8;
            const unsigned alld = df[0] & df[1] & df[2] & df[3] & df[4] & df[5] & df[6] & df[7];
            if (alld) break;
        }
        if (MODE != 2 && it + 1 < nkt) LOAD_TILE(kt - 1);
        LAS unsigned char* Kb = lds + buf * BUFB; LAS unsigned char* Vb = Kb + VOFF;
#pragma unroll 1
        for (int subi = 0; subi < 2; ++subi) {
            const int sub = 1 - subi;
            const int s0 = kt * 64 + 32 * sub;
            if (s0 > t0) continue;
            const int relb = t0 - s0 + r - 4 * hh;
            __builtin_amdgcn_sched_barrier(0);
            float pv[16];
#pragma unroll
            for (int p = 0; p < NMAP; ++p) {
                f32x16 sacc;
#pragma unroll
                for (int i = 0; i < 16; ++i) sacc[i] = 0.f;
                constexpr int NST = NQS / NMAP;
#pragma unroll
                for (int st = 0; st < NST; ++st) {
                    const int sq = p * NST + st;
                    const bf16x8 kf = *(const LAS bf16x8*)(Kb + (32 * sub + r) * KP + (16 * sq + 8 * hh) * 2);
                    sacc = MFMA32(kf, __builtin_bit_cast(bf16x8, qf[sq]), sacc);
                }
                if (MODE == 0) {
#pragma unroll
                    for (int i = 0; i < 16; ++i) { const int rel = relb - ((i & 3) + 8 * (i >> 2));
                        const float f = __builtin_amdgcn_exp2f((float)rel * lg2) * 0.08838834764831845f;
                        pv[i] = (rel >= 0) ? sacc[i] * f : 0.f; }
                } else if (MODE == 1) {
                    float L[16], ls[16], c[16], gs[4], pg[4], suf[4];
#pragma unroll
                    for (int i = 0; i < 16; ++i) { const int rel = relb - ((i & 3) + 8 * (i >> 2));
                        const float z = sacc[i] * 0.125f; const float lp = __logf(1.f + __expf(-fabsf(z)));
                        const float lsi = fminf(z, 0.f) - lp; ls[i] = lsi; L[i] = (rel > 0) ? (lsi - z) : 0.f; }
#pragma unroll
                    for (int g = 0; g < 4; ++g) { c[4 * g + 3] = 0.f; c[4 * g + 2] = L[4 * g + 3]; c[4 * g + 1] = c[4 * g + 2] + L[4 * g + 2]; c[4 * g] = c[4 * g + 1] + L[4 * g + 1];
                        gs[g] = c[4 * g] + L[4 * g]; pg[g] = __shfl_xor(gs[g], 32); }
                    float run = 0.f;
#pragma unroll
                    for (int g = 3; g >= 0; --g) { suf[g] = run + (hh == 0 ? pg[g] : 0.f); run += gs[g] + pg[g]; }
#pragma unroll
                    for (int i = 0; i < 16; ++i) { const int rel = relb - ((i & 3) + 8 * (i >> 2));
                        const float e = __expf(ls[i] + Rrun + suf[i >> 2] + c[i]); pv[i] = (rel > 0) ? e : 0.f; }
                    Rrun += run;
                } else {
                    const bool far = (t0 - s0 - 31) >= 128;
                    float sv[16]; float mx = -INFINITY;
                    if (far) {
                        const float bfar = biasT[128];
#pragma unroll
                        for (int i = 0; i < 16; ++i) { const float v = sacc[i] * (0.125f * LOG2E) + bfar; sv[i] = v; mx = fmaxf(mx, v); }
                    } else {
#pragma unroll
                        for (int i = 0; i < 16; ++i) { const int rel = relb - ((i & 3) + 8 * (i >> 2));
                            const int ri = rel < 0 ? 0 : (rel > 128 ? 128 : rel);
                            float v = sacc[i] * (0.125f * LOG2E) + biasT[ri];
                            if (rel < 0) v = -INFINITY;
                            sv[i] = v; mx = fmaxf(mx, v); }
                    }
                    if (statpass) {
                        mx = fmaxf(mx, __shfl_xor(mx, 32));
                        const float mnew = fmaxf(mrun[p], mx);
                        const float al = __builtin_amdgcn_exp2f(mrun[p] - mnew);
                        float sm = 0.f;
#pragma unroll
                        for (int i = 0; i < 16; ++i) sm += __builtin_amdgcn_exp2f(sv[i] - mnew);
                        sm += __shfl_xor(sm, 32);
                        lrun[p] = lrun[p] * al + sm; mrun[p] = mnew;
                    } else {
                        const float mm = mrun[p], cc = cmul[p];
                        if (p == 0) {
#pragma unroll
                            for (int i = 0; i < 16; ++i) pv[i] = __builtin_amdgcn_exp2f(sv[i] - mm) * cc;
                        } else {
#pragma unroll
                            for (int i = 0; i < 16; ++i) pv[i] -= __builtin_amdgcn_exp2f(sv[i] - mm) * cc;
                        }
                    }
                }
            }
            __builtin_amdgcn_sched_barrier(0);
            if (statpass) continue;
#pragma unroll
            for (int ss = 0; ss < 2; ++ss) {
                const bf16x8 pb = pack8(pv[8 * ss], pv[8 * ss + 1], pv[8 * ss + 2], pv[8 * ss + 3], pv[8 * ss + 4], pv[8 * ss + 5], pv[8 * ss + 6], pv[8 * ss + 7]);
#pragma unroll
                for (int dt = 0; dt < NDT; ++dt) {
                    const LAS unsigned char* vp = Vb + (32 * dt + r) * VP + (32 * sub + 16 * ss + 4 * hh) * 2;
                    const s16x4 lo = *(const LAS s16x4*)vp; const s16x4 hi = *(const LAS s16x4*)(vp + 16);
                    const bf16x8 vf = __builtin_shufflevector(lo, hi, 0, 1, 2, 3, 4, 5, 6, 7);
                    oacc[dt] = MFMA32(vf, pb, oacc[dt]);
                }
            }
        }
        if (MODE == 1) { const int dn = __all(Rrun < -120.f); if (lane == 0) dflag[(it & 1) * 8 + wid] = dn ? 1u : 0u; }
    }
    }
#undef LOAD_TILE
#undef WRITE_TILE
    bf16_t* yrow = Y + (rowb + t) * D_MODEL + ycol + 4 * hh;
    if (MODE == 0) {
        float s = 0.f;
#pragma unroll
        for (int dt = 0; dt < NDT; ++dt)
#pragma unroll
            for (int i = 0; i < 16; ++i) s += oacc[dt][i];
        s += __shfl_xor(s, 32);
        const float mean = s * (1.f / 128.f); float q = 0.f;
#pragma unroll
        for (int dt = 0; dt < NDT; ++dt)
#pragma unroll
            for (int i = 0; i < 16; ++i) { const float d = oacc[dt][i] - mean; q += d * d; }
        q += __shfl_xor(q, 32);
        const float rstd = 1.f / sqrtf(q * (1.f / 128.f) + LN_EPS);
        const bf16_t* grow = H + (rowb + t) * pitch + 1536 + hd * 128 + 4 * hh;
#pragma unroll
        for (int dt = 0; dt < NDT; ++dt)
#pragma unroll
            for (int g = 0; g < 4; ++g) {
                const u32x2 gw = *(const u32x2*)(grow + 32 * dt + 8 * g);
                const float g0 = bflo(gw.x), g1 = bfhi(gw.x), g2 = bflo(gw.y), g3 = bfhi(gw.y);
                const float o0 = (oacc[dt][4 * g] - mean) * rstd * (g0 / (1.f + __expf(-g0)));
                const float o1 = (oacc[dt][4 * g + 1] - mean) * rstd * (g1 / (1.f + __expf(-g1)));
                const float o2 = (oacc[dt][4 * g + 2] - mean) * rstd * (g2 / (1.f + __expf(-g2)));
                const float o3 = (oacc[dt][4 * g + 3] - mean) * rstd * (g3 / (1.f + __expf(-g3)));
                u32x2 w; w.x = cvt_pk_bf16(o0, o1); w.y = cvt_pk_bf16(o2, o3);
                *(u32x2*)(yrow + 32 * dt + 8 * g) = w;
            }
    } else if (MODE == 1) {
#pragma unroll
        for (int dt = 0; dt < NDT; ++dt)
#pragma unroll
            for (int g = 0; g < 4; ++g) {
                u32x2 w; w.x = cvt_pk_bf16(oacc[dt][4 * g], oacc[dt][4 * g + 1]); w.y = cvt_pk_bf16(oacc[dt][4 * g + 2], oacc[dt][4 * g + 3]);
                *(u32x2*)(yrow + 32 * dt + 8 * g) = w;
            }
    } else {
        const int li = layer >> 1;
        float q = 0.f;
#pragma unroll
        for (int dt = 0; dt < NDT; ++dt)
#pragma unroll
            for (int i = 0; i < 16; ++i) { const float o = oacc[dt][i]; q += o * o; }
        q += __shfl_xor(q, 32);
        const float rs = (1.f / sqrtf(q * (1.f / 128.f) + LN_EPS)) * (1.f - lam_init);
        const float* sg = a.in[9] + li * 128 + 4 * hh;
#pragma unroll
        for (int dt = 0; dt < NDT; ++dt)
#pragma unroll
            for (int g = 0; g < 4; ++g) {
                const f32x4 gv = *(const f32x4*)(sg + 32 * dt + 8 * g);
                u32x2 w; w.x = cvt_pk_bf16(oacc[dt][4 * g] * rs * gv[0], oacc[dt][4 * g + 1] * rs * gv[1]);
                w.y = cvt_pk_bf16(oacc[dt][4 * g + 2] * rs * gv[2], oacc[dt][4 * g + 3] * rs * gv[3]);
                *(u32x2*)(yrow + 32 * dt + 8 * g) = w;
            }
    }
}

DI void mixer_phase(LAS unsigned char* lds, const Args& a, const int layer) {
    PHASE_IDS;
    const bool even = (layer & 1) == 0;
    const bf16_t* H0 = (const bf16_t*)(a.ws + WS_H); bf16_t* Y0 = (bf16_t*)(a.ws + WS_Y);
    unsigned* ctr = (unsigned*)(a.ws + WS_CTL) + 64 * layer;
    LAS unsigned* qslot = (LAS unsigned*)(lds + 90112);
    const int NU = even ? 1536 : 1024;
    for (;;) {
        __syncthreads();
        if (tid == 0) qslot[0] = atomicAdd(ctr, 1u);
        __syncthreads();
        const int u = (int)qslot[0];
        if (u >= NU) break;
        const bf16_t* H = H0; bf16_t* Y = Y0; OPAQUE(H); OPAQUE(Y);
        if (even) {
            const int qi = u / 192, rem = u - qi * 192, qb = 7 - qi;
            if (rem < 64) attn_unit<0>(lds, a, H, EVEN_IN, Y, rem >> 2, rem & 3, qb, layer);
            else { const int r2 = rem - 64; attn_unit<1>(lds, a, H, EVEN_IN, Y, r2 >> 3, r2 & 7, qb, layer); }
        } else {
            const int qi = u >> 7, rem = u & 127, qb = 7 - qi;
            attn_unit<2>(lds, a, H, ODD_IN, Y, rem >> 3, rem & 7, qb, layer);
        }
    }
}

__global__ void __launch_bounds__(NTHR, 2) fwd_megakernel(Args a) {
    extern __shared__ __attribute__((aligned(16))) unsigned char lds_raw[];
    LAS unsigned char* lds = (LAS unsigned char*)lds_raw;
    cg::grid_group grid = cg::this_grid();
    const int G = gridDim.x, cid = blockIdx.x;
    float* X = a.out;
    bf16_t* XB = (bf16_t*)(a.ws + WS_XB);
    bf16_t* Hb = (bf16_t*)(a.ws + WS_H); bf16_t* Yb = (bf16_t*)(a.ws + WS_Y);
    bf16_t* HUP = (bf16_t*)(a.ws + WS_HUP); bf16_t* Ab = (bf16_t*)(a.ws + WS_A);
    const bf16_t* Win_t = (const bf16_t*)(a.ws + WS_WIN); const bf16_t* Wout_t = (const bf16_t*)(a.ws + WS_WOUT);
    const bf16_t* Wup_t = (const bf16_t*)(a.ws + WS_WUP); const bf16_t* Wdn_t = (const bf16_t*)(a.ws + WS_WDN);

    prologue(a, lds);
    grid.sync();

    for (int l = 0; l < DEPTH; ++l) {
        const bool even = (l & 1) == 0; const int Nin = even ? EVEN_IN : ODD_IN;
        { const bf16_t* pa = XB; const bf16_t* pb = Win_t; bf16_t* po = Hb; OPAQUE(pa); OPAQUE(pb); OPAQUE(po); pg8::Gemm g{pa, pb, MTOK, Nin, D_MODEL}; pg8::StaticOrder S; S.init(MTOK, Nin, G, cid);
          pg8::EpiBf16 E{po, Nin};
          pg8::gemm_phase<pg8::EpiBf16, pg8::StaticOrder, true, true>(lds, g, S, E); }
        grid.sync();
        mixer_phase(lds, a, l);
        grid.sync();
        { const bf16_t* pa = Yb; const bf16_t* pb = Wout_t; float* po = X; OPAQUE(pa); OPAQUE(pb); OPAQUE(po); pg8::Gemm g{pa, pb, MTOK, D_MODEL, D_MODEL}; pg8::StaticOrder S; S.init(MTOK, D_MODEL, G, cid);
          pg8::EpiResid E{po, ALPHA};
          pg8::gemm_phase<pg8::EpiResid, pg8::StaticOrder, true, true>(lds, g, S, E); }
        grid.sync();
        { float* px = X; bf16_t* pxb = XB; const float* pg = a.in[15] + l * D_MODEL; const float* pbt = a.in[16] + l * D_MODEL; OPAQUE(px); OPAQUE(pxb); OPAQUE(pg); OPAQUE(pbt); ln_phase(px, pxb, pg, pbt); }
        grid.sync();
        for (int half = 0; half < 2; ++half) {
            { const bf16_t* pa = XB + (size_t)half * HALF_ROWS * D_MODEL; const bf16_t* pb = Wup_t; bf16_t* po = HUP; OPAQUE(pa); OPAQUE(pb); OPAQUE(po); pg8::Gemm g{pa, pb, HALF_ROWS, FF2, D_MODEL}; pg8::StaticOrder S; S.init(HALF_ROWS, FF2, G, cid);
              pg8::EpiBf16 E{po, FF2};
              pg8::gemm_phase<pg8::EpiBf16, pg8::StaticOrder, true, true>(lds, g, S, E); }
            grid.sync();
            { const bf16_t* ph = HUP; bf16_t* pa2 = Ab; const float* pcw = a.in[12] + (size_t)l * 3 * FF2; const float* pcb = a.in[13] + (size_t)l * FF2; OPAQUE(ph); OPAQUE(pa2); OPAQUE(pcw); OPAQUE(pcb); convgate_phase(ph, pa2, pcw, pcb, half); }
            grid.sync();
        }
        { const bf16_t* pa = Ab; const bf16_t* pb = Wdn_t; float* po = X; OPAQUE(pa); OPAQUE(pb); OPAQUE(po); pg8::Gemm g{pa, pb, MTOK, D_MODEL, D_FF}; pg8::StaticOrder S; S.init(MTOK, D_MODEL, G, cid);
          pg8::EpiResid E{po, ALPHA};
          pg8::gemm_phase<pg8::EpiResid, pg8::StaticOrder, true, true>(lds, g, S, E); }
        grid.sync();
        { float* px = X; bf16_t* pxb = XB; const float* pg = a.in[17] + l * D_MODEL; const float* pbt = a.in[18] + l * D_MODEL; OPAQUE(px); OPAQUE(pxb); OPAQUE(pg); OPAQUE(pbt); ln_phase(px, pxb, pg, pbt); }
        if (l + 1 < DEPTH) convert_weights(a, l + 1, lds);
        grid.sync();
    }
}

extern "C" void kernel_launch(void* const* d_in, const int* in_sizes, int n_in, void* d_out, int out_size, void* d_ws, size_t ws_size, hipStream_t stream) {
    static int grid = 0;
    if (grid == 0) {
        if (n_in != 19 || out_size != MTOK * D_MODEL || ws_size < WS_END) { fprintf(stderr, "kernel_launch: unexpected shapes (n_in %d out %d ws %zu)\n", n_in, out_size, ws_size); grid = -1; return; }
        int dev = 0, cus = 0, per_cu = 0;
        hipGetDevice(&dev);
        hipDeviceGetAttribute(&cus, hipDeviceAttributeMultiprocessorCount, dev);
        if (hipFuncSetAttribute((const void*)fwd_megakernel, hipFuncAttributeMaxDynamicSharedMemorySize, LDS_BYTES) != hipSuccess) { fprintf(stderr, "kernel_launch: hipFuncSetAttribute failed\n"); grid = -1; return; }
        if (hipOccupancyMaxActiveBlocksPerMultiprocessor(&per_cu, (const void*)fwd_megakernel, NTHR, LDS_BYTES) != hipSuccess || per_cu < 1) { fprintf(stderr, "kernel_launch: occupancy query gives %d\n", per_cu); per_cu = 1; }
        (void)hipGetLastError();
        grid = cus * 1;
    }
    if (grid < 0) return;
    Args a{};
    for (int i = 0; i < 19; ++i) a.in[i] = (const float*)d_in[i];
    a.out = (float*)d_out; a.ws = (unsigned char*)d_ws;
    void* args[] = {&a};
    hipError_t e = hipLaunchCooperativeKernel((const void*)fwd_megakernel, dim3(grid), dim3(NTHR), args, LDS_BYTES, stream);
    if (e != hipSuccess) fprintf(stderr, "cooperative launch failed: %s (grid %d)\n", hipGetErrorString(e), grid);
}
```

```cpp
#include <hip/hip_runtime.h>
#include <hip/hip_cooperative_groups.h>
#include <cstdio>
#include <cstdint>
namespace cg = cooperative_groups;
namespace pg8 {
#define PG8_LAS __attribute__((address_space(3)))
typedef unsigned short bf16_t;
typedef short bf16x8 __attribute__((ext_vector_type(8)));
typedef float f32x4 __attribute__((ext_vector_type(4)));
typedef unsigned u32x4 __attribute__((ext_vector_type(4)));
constexpr int BM = 256, BK = 64, HALF = 128, HTB = HALF * BK * 2  , STAGE_BYTES = 8 * HTB, NXCD = 8, WGM = 8;

__host__ __device__ __forceinline__ int lds_byte(int r, int c) { const int st = (r >> 4) * 2 + (c >> 5), rr = r & 15, cc = c & 31, ob = rr * 64 + cc * 2; return st * 1024 + (ob ^ (((ob >> 9) & 1) << 5)); }
__host__ __device__ __forceinline__ void stage_rc(int b, int& R, int& C) { const int st = b / 1024, sb = b % 1024, swz = sb ^ (((sb >> 9) & 1) << 5); R = (st >> 1) * 16 + swz / 64; C = (st & 1) * 32 + (swz % 64) / 2; }
__host__ __device__ __forceinline__ int perm32(int rho) { const int n = rho >> 4, i = rho & 15; return 8 * (i >> 2) + 4 * n + (i & 3); }

struct Unit { int pm, pn; };
struct Gemm { const bf16_t* A; const bf16_t* Bt; int M, N, K; };

struct StaticOrder {
    int nM, nN, nwg, G, c;
    __host__ __device__ void init(int M, int N, int G_, int c_) { nM = M / BM; nN = N / BM; nwg = nM * nN; G = G_; c = c_; }
    __host__ __device__ bool next(int i, Unit& u) const {
        const long L = (long)i * G + c; if (L >= nwg) return false;
        int wgid = (int)L; { const int q = nwg / NXCD, r = nwg % NXCD, xcd = wgid % NXCD, off = wgid / NXCD; wgid = (xcd < r ? xcd * (q + 1) : r * (q + 1) + (xcd - r) * q) + off; }
        const int nig = WGM * nN, gid = wgid / nig, fm = gid * WGM, gsz = (nM - fm) < WGM ? (nM - fm) : WGM;
        u.pm = fm + ((wgid % nig) % gsz); u.pn = (wgid % nig) / gsz; return true;
    }
    __device__ __forceinline__ void a_ready(const Unit&) const {}
    __device__ __forceinline__ void done(const Unit&) const {}
};
__device__ __forceinline__ unsigned cvt_pk_bf16(float lo, float hi) { unsigned r; asm volatile("v_cvt_pk_bf16_f32 %0, %1, %2" : "=v"(r) : "v"(lo), "v"(hi)); return r; }
typedef float f32x2 __attribute__((ext_vector_type(2)));
struct EpiBf16 {
    static constexpr bool PERM = true, AFTER_DRAIN = false;
    bf16_t* O; int ldc;
    __device__ __forceinline__ void operator()(const f32x4 (&acc)[2][2][4][2], const Unit& u, int wr, int wc, int fr, int fq) const {
        const int row0 = u.pm * BM + wr * 64 + fr; const int col0 = u.pn * BM + wc * 32 + 8 * fq;
#pragma unroll
        for (int ai = 0; ai < 2; ++ai)
#pragma unroll
            for (int m = 0; m < 4; ++m) { bf16_t* rowp = O + (size_t)(row0 + ai * HALF + m * 16) * ldc + col0;
#pragma unroll
                for (int bj = 0; bj < 2; ++bj) { const f32x4 v0 = acc[ai][bj][m][0], v1 = acc[ai][bj][m][1];
                    u32x4 w; w.x = cvt_pk_bf16(v0[0], v0[1]); w.y = cvt_pk_bf16(v0[2], v0[3]); w.z = cvt_pk_bf16(v1[0], v1[1]); w.w = cvt_pk_bf16(v1[2], v1[3]);
                    *(u32x4*)(rowp + bj * HALF) = w; } }
    }
};
struct EpiResid {
    static constexpr bool PERM = false, AFTER_DRAIN = false;
    float* X; float alpha;
    __device__ __forceinline__ void operator()(const f32x4 (&acc)[2][2][4][2], const Unit& u, int wr, int wc, int fr, int fq) const {
        float* p = X + (size_t)(u.pm * BM + wr * 64 + fr) * 1024 + u.pn * BM + wc * 32 + 4 * fq;
#pragma unroll
        for (int ai = 0; ai < 2; ++ai)
#pragma unroll
            for (int m = 0; m < 4; ++m) { float* q = p + (ai * HALF + m * 16) * 1024;
                asm volatile("" : "+v"(q));
#pragma unroll
                for (int bj = 0; bj < 2; ++bj)
#pragma unroll
                    for (int n = 0; n < 2; ++n) { const f32x4 x = *(const f32x4*)(q + bj * HALF + n * 16);
                        *(f32x4*)(q + bj * HALF + n * 16) = acc[ai][bj][m][n] + alpha * x; }
                asm volatile("" ::: "memory"); }
    }
};

#define PG8_DPP(old, src, ctrl, bc) __builtin_bit_cast(float, __builtin_amdgcn_update_dpp(__builtin_bit_cast(int, (float)(old)), __builtin_bit_cast(int, (float)(src)), (ctrl), 0xf, 0xf, (bc)))
struct EpiConvGate {
    static constexpr bool PERM = true, AFTER_DRAIN = false;
    bf16_t* A; const float* cw; const float* cb; float* RAW; PG8_LAS unsigned char* pub;
    __device__ __forceinline__ void operator()(const f32x4 (&acc)[2][2][4][2], const Unit& u, int wr, int wc, int fr, int fq) const {
        constexpr int FF = 2816, FF2 = 5632;
        if (fr >= 14) {
#pragma unroll
            for (int ai = 0; ai < 2; ++ai)
#pragma unroll
                for (int bj = 0; bj < 2; ++bj)
#pragma unroll
                    for (int n = 0; n < 2; ++n)
                        *(PG8_LAS f32x4*)(pub + ((((((ai * 2 + wr) * 4 + wc) * 2 + bj) * 2 + n) * 4 + fq) * 2 + (fr - 14)) * 16) = acc[ai][bj][3][n];
        }
        asm volatile("s_waitcnt lgkmcnt(0)" ::: "memory"); __builtin_amdgcn_s_barrier(); asm volatile("" ::: "memory");
        const int cbase = u.pn * 128 + wc * 32 + 8 * fq;
        if (wr == 0 && fr < 2) {
#pragma unroll
            for (int bj = 0; bj < 2; ++bj)
#pragma unroll
                for (int n = 0; n < 2; ++n) *(f32x4*)(RAW + ((size_t)u.pm * 4 + fr) * FF2 + bj * FF + cbase + 4 * n) = acc[0][bj][0][n];
        }
        if (wr == 1 && fr >= 14) {
#pragma unroll
            for (int bj = 0; bj < 2; ++bj)
#pragma unroll
                for (int n = 0; n < 2; ++n) *(f32x4*)(RAW + ((size_t)u.pm * 4 + 2 + (fr - 14)) * FF2 + bj * FF + cbase + 4 * n) = acc[1][bj][3][n];
        }
#pragma unroll
        for (int n = 0; n < 2; ++n) {
            const int c = cbase + 4 * n;
            const f32x4 wu0 = *(const f32x4*)(cw + c), wu1 = *(const f32x4*)(cw + FF2 + c), wu2 = *(const f32x4*)(cw + 2 * FF2 + c), bu = *(const f32x4*)(cb + c);
            const f32x4 wg0 = *(const f32x4*)(cw + FF + c), wg1 = *(const f32x4*)(cw + FF2 + FF + c), wg2 = *(const f32x4*)(cw + 2 * FF2 + FF + c), bg = *(const f32x4*)(cb + FF + c);
#pragma unroll
            for (int ai = 0; ai < 2; ++ai) {
                const int qidx = ai * 2 + wr;
                f32x4 pu = {0.f, 0.f, 0.f, 0.f}, pg = {0.f, 0.f, 0.f, 0.f};
                if (qidx > 0 && fr >= 14) {
                    pu = *(const PG8_LAS f32x4*)(pub + (((((((qidx - 1) * 4 + wc) * 2 + 0) * 2 + n) * 4 + fq) * 2 + (fr - 14)) * 16));
                    pg = *(const PG8_LAS f32x4*)(pub + (((((((qidx - 1) * 4 + wc) * 2 + 1) * 2 + n) * 4 + fq) * 2 + (fr - 14)) * 16));
                }
#pragma unroll
                for (int m = 0; m < 4; ++m) {
                    const f32x4 xu = acc[ai][0][m][n], xg = acc[ai][1][m][n];
                    float o[4];
#pragma unroll
                    for (int e = 0; e < 4; ++e) {
                        const float tu1 = PG8_DPP(0.f, pu[e], 0x10F, true), hu1 = PG8_DPP(tu1, xu[e], 0x111, false);
                        const float tu2 = PG8_DPP(0.f, pu[e], 0x10E, true), hu2 = PG8_DPP(tu2, xu[e], 0x112, false);
                        const float tg1 = PG8_DPP(0.f, pg[e], 0x10F, true), hg1 = PG8_DPP(tg1, xg[e], 0x111, false);
                        const float tg2 = PG8_DPP(0.f, pg[e], 0x10E, true), hg2 = PG8_DPP(tg2, xg[e], 0x112, false);
                        const float uc = wu2[e] * xu[e] + wu1[e] * hu1 + wu0[e] * hu2 + bu[e];
                        const float gc = wg2[e] * xg[e] + wg1[e] * hg1 + wg0[e] * hg2 + bg[e];
                        o[e] = gc / (1.f + __expf(-gc)) * uc;
                    }
                    pu = xu; pg = xg;
                    if (!(qidx == 0 && m == 0 && fr < 2)) {
                        typedef unsigned u32x2e __attribute__((ext_vector_type(2)));
                        u32x2e w; w.x = cvt_pk_bf16(o[0], o[1]); w.y = cvt_pk_bf16(o[2], o[3]);
                        *(u32x2e*)(A + (size_t)(u.pm * BM + ai * HALF + wr * 64 + m * 16 + fr) * FF + c) = w;
                    }
                }
            }
        }
    }
};
template <class Epi, class Sched, bool ALIGN_EPI = false, bool SP2 = false>
__device__ __forceinline__ void gemm_phase(PG8_LAS unsigned char* lds, const Gemm g, const Sched& S, const Epi& E) {
    int tid = threadIdx.x; asm volatile("" : "+v"(tid));
    const int wid = __builtin_amdgcn_readfirstlane(tid >> 6), lane = tid & 63, wr = wid >> 2, wc = wid & 3, fr = lane & 15, fq = lane >> 4;
    const int K = g.K, nt = K / BK;
    unsigned voffA[2], voffB[2];
#pragma unroll
    for (int i = 0; i < 2; ++i) { int R, C; stage_rc(tid * 16 + i * 8192, R, C); const int Rb = Epi::PERM ? ((R & ~31) + perm32(R & 31)) : R;
        voffA[i] = (unsigned)(R * K + C) * 2u; voffB[i] = (unsigned)(Rb * K + C) * 2u; }
    const size_t kstep = (size_t)(BK * 2);
    const size_t hstep = (size_t)HALF * K * 2;
    const size_t tstep = 2 * hstep;
    const unsigned ldsw = (unsigned)wid * 1024u;
    const int aoff = lds_byte(wr * 64 + fr, fq * 8), boff = lds_byte(wc * 32 + fr, fq * 8);
#define PG8_SA(b, h) (((b) * 2 + (h)) * HTB)
#define PG8_SB(b, h) ((4 + (b) * 2 + (h)) * HTB)
#define PG8_STAGE(bufoff, gbase, voff) do { _Pragma("unroll") for (int _i = 0; _i < 2; ++_i) \
        __builtin_amdgcn_global_load_lds((const unsigned*)((const char*)(gbase) + (voff)[_i]), (PG8_LAS unsigned*)(lds + (bufoff) + ldsw + _i * 8192), 16, 0, 0); } while (0)
#define PG8_LDA(dst, b, h) do { _Pragma("unroll") for (int m = 0; m < 4; ++m) _Pragma("unroll") for (int k = 0; k < 2; ++k) dst[m][k] = *(const PG8_LAS bf16x8*)(lds + PG8_SA(b, h) + aoff + m * 2048 + k * 1024); } while (0)
#define PG8_LDB(dst, b, h) do { _Pragma("unroll") for (int n = 0; n < 2; ++n) _Pragma("unroll") for (int k = 0; k < 2; ++k) dst[n][k] = *(const PG8_LAS bf16x8*)(lds + PG8_SB(b, h) + boff + n * 2048 + k * 1024); } while (0)
#define PG8_MMA(ai, bj, At, Bt) do { __builtin_amdgcn_s_setprio(1); _Pragma("unroll") for (int m = 0; m < 4; ++m) _Pragma("unroll") for (int n = 0; n < 2; ++n) _Pragma("unroll") for (int k = 0; k < 2; ++k) \
        acc[ai][bj][m][n] = __builtin_amdgcn_mfma_f32_16x16x32_bf16(Bt[n][k], At[m][k], acc[ai][bj][m][n], 0, 0, 0); __builtin_amdgcn_s_setprio(0); } while (0)
#define PG8_WAIT_V(n) asm volatile("s_waitcnt vmcnt(" #n ")" ::: "memory")
#define PG8_WAIT_L(n) asm volatile("s_waitcnt lgkmcnt(" #n ")" ::: "memory")
#define PG8_BAR __builtin_amdgcn_s_barrier()
#define PG8_SCHED __builtin_amdgcn_sched_barrier(0)
    Unit cur, nxt; int ui = 0;
    if (!S.next(0, cur)) return;
    f32x4 acc[2][2][4][2];
#pragma unroll
    for (int a = 0; a < 2; ++a)
#pragma unroll
        for (int b = 0; b < 2; ++b)
#pragma unroll
            for (int m = 0; m < 4; ++m)
#pragma unroll
                for (int n = 0; n < 2; ++n) acc[a][b][m][n] = (f32x4){0.f, 0.f, 0.f, 0.f};
    bf16x8 At[4][2], B0[2][2], B1[2][2];
    const char* cA = (const char*)g.A + (size_t)cur.pm * tstep; const char* cB = (const char*)g.Bt + (size_t)cur.pn * tstep;
    S.a_ready(cur);
    if constexpr (SP2) {
        PG8_STAGE(PG8_SB(0, 0), cB, voffB); PG8_STAGE(PG8_SB(0, 1), cB + hstep, voffB); PG8_STAGE(PG8_SA(0, 0), cA, voffA); PG8_STAGE(PG8_SA(0, 1), cA + hstep, voffA);
        if (wr == 1) PG8_BAR;
        PG8_WAIT_V(2); PG8_BAR;
        PG8_STAGE(PG8_SB(1, 0), cB + kstep, voffB); PG8_STAGE(PG8_SA(1, 0), cA + kstep, voffA); PG8_STAGE(PG8_SB(1, 1), cB + hstep + kstep, voffB);
        PG8_WAIT_V(6); PG8_BAR;
    } else {
        PG8_STAGE(PG8_SB(0, 0), cB, voffB); PG8_STAGE(PG8_SA(0, 0), cA, voffA); PG8_STAGE(PG8_SB(0, 1), cB + hstep, voffB); PG8_STAGE(PG8_SA(0, 1), cA + hstep, voffA);
        if (wr == 1) PG8_BAR;
        PG8_WAIT_V(4); PG8_BAR;
        PG8_STAGE(PG8_SB(1, 0), cB + kstep, voffB); PG8_STAGE(PG8_SA(1, 0), cA + kstep, voffA); PG8_STAGE(PG8_SB(1, 1), cB + hstep + kstep, voffB);
        PG8_WAIT_V(6); PG8_BAR;
    }
    for (;;) {
        const bool has_next = S.next(ui + 1, nxt);
        const char* nA = has_next ? (const char*)g.A + (size_t)nxt.pm * tstep : cA; const char* nB = has_next ? (const char*)g.Bt + (size_t)nxt.pn * tstep : cB;
        for (int t = 0; t < nt; t += 2) {
            const bool last = (t == nt - 2);
            const char* a1 = cA + (size_t)(t + 1) * kstep;
            const char* a2 = last ? nA : cA + (size_t)(t + 2) * kstep; const char* b2 = last ? nB : cB + (size_t)(t + 2) * kstep;
            const char* a3 = a2 + kstep; const char* b3 = b2 + kstep;
            if (last && has_next) S.a_ready(nxt);
            if constexpr (SP2) {
            PG8_LDB(B0, 0, 0); PG8_LDB(B1, 0, 1); PG8_SCHED; PG8_LDA(At, 0, 0); PG8_STAGE(PG8_SA(1, 1), a1 + hstep, voffA);
            PG8_WAIT_V(8); PG8_WAIT_L(0); PG8_BAR; PG8_MMA(0, 0, At, B0); PG8_MMA(0, 1, At, B1); PG8_BAR; PG8_SCHED;
            PG8_LDA(At, 0, 1); PG8_STAGE(PG8_SB(0, 0), b2, voffB); PG8_STAGE(PG8_SB(0, 1), b2 + hstep, voffB); PG8_STAGE(PG8_SA(0, 0), a2, voffA);
            PG8_WAIT_V(8); PG8_WAIT_L(0); PG8_BAR; PG8_MMA(1, 0, At, B0); PG8_MMA(1, 1, At, B1); PG8_BAR; PG8_SCHED;
            PG8_LDB(B0, 1, 0); PG8_LDB(B1, 1, 1); PG8_SCHED; PG8_LDA(At, 1, 0); PG8_STAGE(PG8_SA(0, 1), a2 + hstep, voffA);
            PG8_WAIT_V(8); PG8_WAIT_L(0); PG8_BAR; PG8_MMA(0, 0, At, B0); PG8_MMA(0, 1, At, B1); PG8_BAR; PG8_SCHED;
            PG8_LDA(At, 1, 1); PG8_STAGE(PG8_SB(1, 0), b3, voffB); PG8_STAGE(PG8_SB(1, 1), b3 + hstep, voffB); PG8_STAGE(PG8_SA(1, 0), a3, voffA);
            PG8_WAIT_V(8); PG8_WAIT_L(0); PG8_BAR; PG8_MMA(1, 0, At, B0); PG8_MMA(1, 1, At, B1); PG8_BAR; PG8_SCHED;
            } else {
            PG8_LDB(B0, 0, 0); PG8_SCHED; PG8_LDA(At, 0, 0); PG8_STAGE(PG8_SA(1, 1), a1 + hstep, voffA);
            PG8_WAIT_L(8); PG8_BAR; PG8_WAIT_L(0); PG8_MMA(0, 0, At, B0); PG8_BAR; PG8_SCHED;
            PG8_LDB(B1, 0, 1); PG8_STAGE(PG8_SB(0, 0), b2, voffB);
            PG8_BAR; PG8_WAIT_L(0); PG8_MMA(0, 1, At, B1); PG8_BAR;
            PG8_LDA(At, 0, 1); PG8_STAGE(PG8_SA(0, 0), a2, voffA);
            PG8_BAR; PG8_WAIT_L(0); PG8_MMA(1, 0, At, B0); PG8_BAR; PG8_SCHED;
            PG8_STAGE(PG8_SB(0, 1), b2 + hstep, voffB);
            PG8_WAIT_V(6); PG8_BAR; PG8_MMA(1, 1, At, B1); PG8_BAR;
            PG8_LDB(B0, 1, 0); PG8_SCHED; PG8_LDA(At, 1, 0); PG8_STAGE(PG8_SA(0, 1), a2 + hstep, voffA);
            PG8_WAIT_L(8); PG8_BAR; PG8_WAIT_L(0); PG8_MMA(0, 0, At, B0); PG8_BAR; PG8_SCHED;
            PG8_LDB(B1, 1, 1); PG8_STAGE(PG8_SB(1, 0), b3, voffB);
            PG8_BAR; PG8_WAIT_L(0); PG8_MMA(0, 1, At, B1); PG8_BAR;
            PG8_LDA(At, 1, 1); PG8_STAGE(PG8_SA(1, 0), a3, voffA);
            PG8_BAR; PG8_WAIT_L(0); PG8_MMA(1, 0, At, B0); PG8_BAR; PG8_SCHED;
            PG8_STAGE(PG8_SB(1, 1), b3 + hstep, voffB);
            PG8_WAIT_V(6); PG8_BAR; PG8_MMA(1, 1, At, B1); PG8_BAR;
            }
        }
        if constexpr (ALIGN_EPI) { if (wr == 0) PG8_BAR; }
        if constexpr (!Epi::AFTER_DRAIN) { E(acc, cur, wr, wc, fr, fq); S.done(cur); }
        if (!has_next) break;
#pragma unroll
        for (int a = 0; a < 2; ++a)
#pragma unroll
            for (int b = 0; b < 2; ++b)
#pragma unroll
                for (int m = 0; m < 4; ++m)
#pragma unroll
                    for (int n = 0; n < 2; ++n) acc[a][b][m][n] = (f32x4){0.f, 0.f, 0.f, 0.f};
        cur = nxt; cA = nA; cB = nB; ++ui;
        if constexpr (ALIGN_EPI) { if (wr == 1) PG8_BAR; }
    }
    PG8_WAIT_V(0);
    if constexpr (!ALIGN_EPI) { if (wr == 0) PG8_BAR; }
    PG8_BAR;
    if constexpr (Epi::AFTER_DRAIN) { E.fused(acc, cur, wr, wc, fr, fq, lds, wid, lane); S.done(cur); }
#undef PG8_SA
#undef PG8_SB
#undef PG8_STAGE
#undef PG8_LDA
#undef PG8_LDB
#undef PG8_MMA
#undef PG8_WAIT_V
#undef PG8_WAIT_L
#undef PG8_BAR
#undef PG8_SCHED
}
}

#define DI __device__ __forceinline__
#define LAS __attribute__((address_space(3)))
using pg8::bf16_t; using pg8::bf16x8; using pg8::f32x4; using pg8::u32x4; using pg8::cvt_pk_bf16;
typedef short s16x4 __attribute__((ext_vector_type(4)));
typedef float f32x16 __attribute__((ext_vector_type(16)));
typedef unsigned u32x2 __attribute__((ext_vector_type(2)));

constexpr int D_MODEL = 1024, BATCH = 16, SEQ = 2048, DEPTH = 4, MTOK = BATCH * SEQ;
constexpr int D_FF = 2816, FF2 = 2 * D_FF, EVEN_IN = 3584, ODD_IN = 3072;
constexpr float ALPHA = 1.681792830507f, LN_EPS = 1e-5f, LOG2E = 1.4426950408889634f;
constexpr int NWAVES = 8, NTHR = 512;
constexpr int LDS_BYTES = 147456;
constexpr int HALF_ROWS = MTOK / 2;

constexpr size_t MiB = 1u << 20;
constexpr size_t WS_CTL = 0, WS_ROPE = 1 * MiB, WS_WIN = 2 * MiB, WS_WOUT = 10 * MiB, WS_WUP = 12 * MiB, WS_WDN = 24 * MiB;
constexpr size_t WS_XB = 32 * MiB, WS_H = 96 * MiB, WS_Y = 320 * MiB, WS_HUP = 96 * MiB, WS_A = 272 * MiB, WS_END = 448 * MiB;

__device__ const float ROPE_INV[64] = {
1.000000000e+00f, 8.659643531e-01f, 7.498942614e-01f, 6.493816376e-01f, 5.623413324e-01f, 4.869675338e-01f, 4.216965139e-01f, 3.651741147e-01f, 3.162277639e-01f, 2.738419771e-01f, 2.371373773e-01f, 2.053525001e-01f, 1.778279394e-01f, 1.539926529e-01f, 1.333521307e-01f, 1.154782027e-01f, 1.000000015e-01f, 8.659642935e-02f, 7.498941571e-02f, 6.493816525e-02f, 5.623413250e-02f, 4.869675264e-02f, 4.216965288e-02f, 3.651741147e-02f, 3.162277490e-02f, 2.738419734e-02f, 2.371373773e-02f, 2.053525113e-02f, 1.778279431e-02f, 1.539926510e-02f, 1.333521493e-02f, 1.154782064e-02f, 9.999999776e-03f, 8.659643121e-03f, 7.498941850e-03f, 6.493816152e-03f, 5.623413250e-03f, 4.869675264e-03f, 4.216964822e-03f, 3.651741194e-03f, 3.162277630e-03f, 2.738419687e-03f, 2.371373586e-03f, 2.053524833e-03f, 1.778279431e-03f, 1.539926510e-03f, 1.333521446e-03f, 1.154781901e-03f, 1.000000047e-03f, 8.659643354e-04f, 7.498942432e-04f, 6.493816618e-04f, 5.623413017e-04f, 4.869675322e-04f, 4.216965172e-04f, 3.651741426e-04f, 3.162277571e-04f, 2.738419571e-04f, 2.371373703e-04f, 2.053525095e-04f, 1.778279402e-04f, 1.539926452e-04f, 1.333521504e-04f, 1.154782003e-04f };
__device__ const unsigned char T5B[129] = {
0, 1, 2, 3, 4, 5, 6, 7, 8, 9, 10, 11, 12, 13, 14, 15, 16, 16, 16, 17, 17, 18, 18, 18, 19, 19, 19, 20, 20, 20, 20, 21, 21, 21, 21, 22, 22, 22, 22, 22, 23, 23, 23, 23, 23, 23, 24, 24, 24, 24, 24, 24, 25, 25, 25, 25, 25, 25, 25, 26, 26, 26, 26, 26, 26, 26, 26, 27, 27, 27, 27, 27, 27, 27, 27, 27, 27, 28, 28, 28, 28, 28, 28, 28, 28, 28, 28, 29, 29, 29, 29, 29, 29, 29, 29, 29, 29, 29, 29, 30, 30, 30, 30, 30, 30, 30, 30, 30, 30, 30, 30, 30, 30, 31, 31, 31, 31, 31, 31, 31, 31, 31, 31, 31, 31, 31, 31, 31, 31 };

struct Args { const float* in[19]; float* out; unsigned char* ws; };
#define OPAQUE(p) asm volatile("" : "+s"(p))
#define PHASE_IDS int tid = threadIdx.x; asm volatile("" : "+v"(tid)); const int lane = tid & 63, wid = __builtin_amdgcn_readfirstlane(tid >> 6); (void)lane; (void)wid

DI float bflo(unsigned w) { return __uint_as_float(w << 16); }
DI float bfhi(unsigned w) { return __uint_as_float(w & 0xffff0000u); }
DI float wave_sum(float v) {
#pragma unroll
    for (int o = 1; o < 64; o <<= 1) v += __shfl_xor(v, o);
    return v;
}
DI unsigned f2bf(float f) { unsigned u = __float_as_uint(f); return (u + 0x7fffu + ((u >> 16) & 1u)) >> 16; }
DI unsigned pk2(float lo, float hi) { return f2bf(lo) | (f2bf(hi) << 16); }

DI void transpose_item(const float* W, int K, int N, bf16_t* WT, LAS float* scr, int item, int lane, bool permff = false) {
    const int nblk = N / 32, kb = item / nblk, nb = item % nblk, k0 = 64 * kb, n0 = 32 * nb;
    const int r0 = !permff ? n0 : (n0 < D_FF ? 256 * (n0 / 128) + (n0 % 128) : 256 * ((n0 - D_FF) / 128) + 128 + ((n0 - D_FF) % 128));
#pragma unroll 8
    for (int i = 0; i < 32; ++i) { const int kk = 2 * i + (lane >> 5); scr[kk * 33 + (lane & 31)] = W[(size_t)(k0 + kk) * N + n0 + (lane & 31)]; }
    asm volatile("s_waitcnt lgkmcnt(0)" ::: "memory");
    const int c = lane & 7;
#pragma unroll
    for (int j = 0; j < 4; ++j) { const int n = (lane >> 3) + 8 * j; const LAS float* s = scr + (8 * c) * 33 + n;
        u32x4 o; o.x = pk2(s[0 * 33], s[1 * 33]); o.y = pk2(s[2 * 33], s[3 * 33]); o.z = pk2(s[4 * 33], s[5 * 33]); o.w = pk2(s[6 * 33], s[7 * 33]);
        *(u32x4*)(WT + (size_t)(r0 + n) * K + k0 + 8 * c) = o; }
    asm volatile("s_waitcnt lgkmcnt(0)" ::: "memory");
}
DI void convert_weights(const Args& a, int l, LAS unsigned char* lds) {
    PHASE_IDS;
    LAS float* scr = (LAS float*)(lds + wid * 16384);
    const int gw = blockIdx.x * NWAVES + wid, NGW = gridDim.x * NWAVES;
    const int li = l >> 1; const bool even = (l & 1) == 0;
    const int Nin = even ? EVEN_IN : ODD_IN;
    const float* Win = even ? a.in[1] + (size_t)li * D_MODEL * EVEN_IN : a.in[3] + (size_t)li * D_MODEL * ODD_IN;
    const float* Wout = (even ? a.in[2] : a.in[4]) + (size_t)li * D_MODEL * D_MODEL;
    const float* Wup = a.in[11] + (size_t)l * D_MODEL * FF2;
    const float* Wdn = a.in[14] + (size_t)l * D_FF * D_MODEL;
    bf16_t* Win_t = (bf16_t*)(a.ws + WS_WIN); bf16_t* Wout_t = (bf16_t*)(a.ws + WS_WOUT); bf16_t* Wup_t = (bf16_t*)(a.ws + WS_WUP); bf16_t* Wdn_t = (bf16_t*)(a.ws + WS_WDN);
    const int I_in = (D_MODEL / 64) * (Nin / 32), I_out = (D_MODEL / 64) * (D_MODEL / 32), I_up = (D_MODEL / 64) * (FF2 / 32), I_dn = (D_FF / 64) * (D_MODEL / 32);
    const int NIT = I_in + I_out + I_up + I_dn;
    for (int it = gw; it < NIT; it += NGW) {
        int r = it;
        if (r < I_in) { transpose_item(Win, D_MODEL, Nin, Win_t, scr, r, lane); continue; } r -= I_in;
        if (r < I_out) { transpose_item(Wout, D_MODEL, D_MODEL, Wout_t, scr, r, lane); continue; } r -= I_out;
        if (r < I_up) { transpose_item(Wup, D_MODEL, FF2, Wup_t, scr, r, lane, true); continue; } r -= I_up;
        transpose_item(Wdn, D_FF, D_MODEL, Wdn_t, scr, r, lane);
    }
}
DI void prologue(const Args& a, LAS unsigned char* lds) {
    PHASE_IDS;
    if (blockIdx.x == 0 && tid < 64) ((unsigned*)(a.ws + WS_CTL))[tid * 64] = 0u;
    convert_weights(a, 0, lds);
    { const f32x4* x4 = (const f32x4*)a.in[0]; u32x2* o = (u32x2*)(a.ws + WS_XB);
      const size_t n4 = (size_t)MTOK * D_MODEL / 4;
      for (size_t i = (size_t)blockIdx.x * NTHR + tid; i < n4; i += (size_t)gridDim.x * NTHR) { const f32x4 v = x4[i]; u32x2 w; w.x = cvt_pk_bf16(v[0], v[1]); w.y = cvt_pk_bf16(v[2], v[3]); o[i] = w; ((f32x4*)a.out)[i] = v; } }
    { float* rp = (float*)(a.ws + WS_ROPE);
      for (int i = blockIdx.x * NTHR + tid; i < SEQ * 64; i += gridDim.x * NTHR) {
          const int pos = i >> 6, fi = i & 63;
          const float ang = (float)pos * ROPE_INV[fi];
          const double rev = (double)ang * 0.15915494309189535; const double fr = rev - __builtin_rint(rev);
          const float f = (float)fr;
          rp[2 * i] = __builtin_amdgcn_cosf(f); rp[2 * i + 1] = __builtin_amdgcn_sinf(f); } }
}

DI void ln_phase(float* X, bf16_t* XB, const float* g, const float* bt) {
    PHASE_IDS;
    const int gw = blockIdx.x * NWAVES + wid, NGW = gridDim.x * NWAVES;
    f32x4 gg[4], bb[4];
#pragma unroll
    for (int j = 0; j < 4; ++j) { gg[j] = ((const f32x4*)g)[lane + 64 * j]; bb[j] = ((const f32x4*)bt)[lane + 64 * j]; }
    for (int row = gw; row < MTOK; row += NGW) {
        f32x4* xr = (f32x4*)(X + (size_t)row * D_MODEL) + lane;
        f32x4 v[4]; float s = 0.f;
#pragma unroll
        for (int j = 0; j < 4; ++j) { v[j] = xr[64 * j]; s += (v[j][0] + v[j][1]) + (v[j][2] + v[j][3]); }
        const float mean = wave_sum(s) * (1.f / D_MODEL); float s2 = 0.f;
#pragma unroll
        for (int j = 0; j < 4; ++j) { v[j] = v[j] - mean; s2 += (v[j][0] * v[j][0] + v[j][1] * v[j][1]) + (v[j][2] * v[j][2] + v[j][3] * v[j][3]); }
        const float rstd = 1.f / sqrtf(wave_sum(s2) * (1.f / D_MODEL) + LN_EPS);
        u32x2* o8 = (u32x2*)(XB + (size_t)row * D_MODEL) + lane;
#pragma unroll
        for (int j = 0; j < 4; ++j) { const f32x4 o = v[j] * rstd * gg[j] + bb[j]; xr[64 * j] = o;
            u32x2 w; w.x = cvt_pk_bf16(o[0], o[1]); w.y = cvt_pk_bf16(o[2], o[3]); o8[64 * j] = w; }
    }
}

DI void conv8(const u32x4 h0, const u32x4 h1, const u32x4 h2, const float* cw, const float* cb, float (&o)[8]) {
    float w0[8], w1[8], w2[8], bb[8];
#pragma unroll
    for (int q = 0; q < 2; ++q) {
        const f32x4 a0 = *(const f32x4*)(cw + 4 * q), a1 = *(const f32x4*)(cw + FF2 + 4 * q), a2 = *(const f32x4*)(cw + 2 * FF2 + 4 * q), ab = *(const f32x4*)(cb + 4 * q);
#pragma unroll
        for (int e = 0; e < 4; ++e) { w0[4 * q + e] = a0[e]; w1[4 * q + e] = a1[e]; w2[4 * q + e] = a2[e]; bb[4 * q + e] = ab[e]; }
    }
#pragma unroll
    for (int k = 0; k < 4; ++k) {
        o[2 * k] = w2[2 * k] * bflo(h0[k]) + w1[2 * k] * bflo(h1[k]) + w0[2 * k] * bflo(h2[k]) + bb[2 * k];
        o[2 * k + 1] = w2[2 * k + 1] * bfhi(h0[k]) + w1[2 * k + 1] * bfhi(h1[k]) + w0[2 * k + 1] * bfhi(h2[k]) + bb[2 * k + 1];
    }
}
DI void convgate_phase(const bf16_t* HUP, bf16_t* A, const float* cw, const float* cb, int half) {
    PHASE_IDS;
    constexpr int NCH = D_FF / 8;
    const int total = HALF_ROWS * NCH;
    for (int idx = blockIdx.x * NTHR + tid; idx < total; idx += gridDim.x * NTHR) {
        const int rl = idx / NCH, ch = idx - rl * NCH, c = ch * 8, tin = rl & (SEQ - 1);
        const bf16_t* hp = HUP + (size_t)rl * FF2 + c;
        const u32x4 z = {0u, 0u, 0u, 0u};
        const u32x4 u0 = *(const u32x4*)hp, g0 = *(const u32x4*)(hp + D_FF);
        const u32x4 u1 = tin >= 1 ? *(const u32x4*)(hp - FF2) : z, g1 = tin >= 1 ? *(const u32x4*)(hp - FF2 + D_FF) : z;
        const u32x4 u2 = tin >= 2 ? *(const u32x4*)(hp - 2 * FF2) : z, g2 = tin >= 2 ? *(const u32x4*)(hp - 2 * FF2 + D_FF) : z;
        float uo[8], go[8];
        conv8(u0, u1, u2, cw + c, cb + c, uo);
        conv8(g0, g1, g2, cw + D_FF + c, cb + D_FF + c, go);
        float r[8];
#pragma unroll
        for (int j = 0; j < 8; ++j) { const float gv = go[j]; r[j] = gv / (1.f + __expf(-gv)) * uo[j]; }
        u32x4 w; w.x = cvt_pk_bf16(r[0], r[1]); w.y = cvt_pk_bf16(r[2], r[3]); w.z = cvt_pk_bf16(r[4], r[5]); w.w = cvt_pk_bf16(r[6], r[7]);
        *(u32x4*)(A + ((size_t)half * HALF_ROWS + rl) * D_FF + c) = w;
    }
}


DI void fixup_phase(const float* RAW, bf16_t* A, const float* cw, const float* cb) {
    PHASE_IDS;
    constexpr int NCH = D_FF / 4, NPM = MTOK / 256;
    const int total = NPM * 2 * NCH;
    for (int idx = blockIdx.x * NTHR + tid; idx < total; idx += gridDim.x * NTHR) {
        const int ch = idx % NCH, pj = idx / NCH, j = pj & 1, pm = pj >> 1, c = ch * 4;
        const bool has_prev = ((pm * 256) & (SEQ - 1)) != 0;
        const float* R = RAW + (size_t)pm * 4 * FF2; const float* Rp = RAW + (size_t)(pm - 1) * 4 * FF2;
        const f32x4 z = {0.f, 0.f, 0.f, 0.f};
        f32x4 cv[2];
#pragma unroll
        for (int ug = 0; ug < 2; ++ug) {
            const int off = ug * D_FF + c;
            const f32x4 h0 = *(const f32x4*)(R + j * FF2 + off);
            const f32x4 t3 = has_prev ? *(const f32x4*)(Rp + 3 * FF2 + off) : z;
            const f32x4 t2 = has_prev ? *(const f32x4*)(Rp + 2 * FF2 + off) : z;
            const f32x4 h1 = (j == 1) ? *(const f32x4*)(R + off) : t3;
            const f32x4 h2 = (j == 1) ? t3 : t2;
            const f32x4 w0 = *(const f32x4*)(cw + off), w1 = *(const f32x4*)(cw + FF2 + off), w2 = *(const f32x4*)(cw + 2 * FF2 + off), bb = *(const f32x4*)(cb + off);
            cv[ug] = w2 * h0 + w1 * h1 + w0 * h2 + bb;
        }
        float o[4];
#pragma unroll
        for (int e = 0; e < 4; ++e) { const float gc = cv[1][e]; o[e] = gc / (1.f + __expf(-gc)) * cv[0][e]; }
        u32x2 w; w.x = cvt_pk_bf16(o[0], o[1]); w.y = cvt_pk_bf16(o[2], o[3]);
        *(u32x2*)(A + (size_t)(pm * 256 + j) * D_FF + c) = w;
    }
}

#define MFMA32(a, b, c) __builtin_amdgcn_mfma_f32_32x32x16_bf16((a), (b), (c), 0, 0, 0)
DI bf16x8 pack8(float f0, float f1, float f2, float f3, float f4, float f5, float f6, float f7) {
    u32x4 p; p.x = cvt_pk_bf16(f0, f1); p.y = cvt_pk_bf16(f2, f3); p.z = cvt_pk_bf16(f4, f5); p.w = cvt_pk_bf16(f6, f7);
    return __builtin_bit_cast(bf16x8, p);
}
DI void rot8(u32x4& a, u32x4& b, const float* tab) {
    const f32x4 t0 = *(const f32x4*)tab, t1 = *(const f32x4*)(tab + 4), t2 = *(const f32x4*)(tab + 8), t3 = *(const f32x4*)(tab + 12);
    float o1[8], o2[8];
#pragma unroll
    for (int k = 0; k < 4; ++k) {
        const f32x4 tt = k == 0 ? t0 : (k == 1 ? t1 : (k == 2 ? t2 : t3));
        const float x1l = bflo(a[k]), x1h = bfhi(a[k]), x2l = bflo(b[k]), x2h = bfhi(b[k]);
        o1[2 * k] = x1l * tt[0] - x2l * tt[1]; o2[2 * k] = x1l * tt[1] + x2l * tt[0];
        o1[2 * k + 1] = x1h * tt[2] - x2h * tt[3]; o2[2 * k + 1] = x1h * tt[3] + x2h * tt[2];
    }
    a.x = cvt_pk_bf16(o1[0], o1[1]); a.y = cvt_pk_bf16(o1[2], o1[3]); a.z = cvt_pk_bf16(o1[4], o1[5]); a.w = cvt_pk_bf16(o1[6], o1[7]);
    b.x = cvt_pk_bf16(o2[0], o2[1]); b.y = cvt_pk_bf16(o2[2], o2[3]); b.z = cvt_pk_bf16(o2[4], o2[5]); b.w = cvt_pk_bf16(o2[6], o2[7]);
}

template <int MODE>
DI void attn_unit(LAS unsigned char* lds, const Args& a, const bf16_t* __restrict__ H, const int pitch, bf16_t* __restrict__ Y,
                  const int b, const int hd, const int qb, const int layer) {
    constexpr int KD = (MODE == 1) ? 64 : 128, DV = (MODE == 1) ? 64 : 128, NQS = KD / 16, NDT = DV / 32, NMAP = (MODE == 2) ? 2 : 1;
    constexpr int KP = KD * 2 + 16, VP = 64 * 2 + 8, BUFB = 36864, VOFF = 18432;
    int tid = threadIdx.x; asm volatile("" : "+v"(tid));
    const int lane = tid & 63, wid = __builtin_amdgcn_readfirstlane(tid >> 6), r = lane & 31, hh = lane >> 5;
    int qcol, kcol, vcol, ycol;
    if (MODE == 0) { qcol = hd * 128; kcol = 512 + hd * 128; vcol = 1024 + hd * 128; ycol = hd * 128; }
    else if (MODE == 1) { qcol = 2048 + hd * 64; kcol = 2560 + hd * 64; vcol = 3072 + hd * 64; ycol = 512 + hd * 64; }
    else { qcol = hd * 128; kcol = 1024 + hd * 128; vcol = 2048 + hd * 128; ycol = hd * 128; }
    const size_t rowb = (size_t)b * SEQ;
    const int t0 = qb * 256 + wid * 32, t = t0 + r;
    const float* rope = (const float*)(a.ws + WS_ROPE);
    LAS float* biasT = (LAS float*)(lds + 81920);
    if (MODE == 2) { if (tid < 129) biasT[tid] = a.in[10][(int)T5B[tid] * 8 + hd] * LOG2E; }

    u32x4 qf[NQS];
    { const bf16_t* qp = H + (rowb + t) * pitch + qcol + 8 * hh;
#pragma unroll
      for (int st = 0; st < NQS; ++st) qf[st] = *(const u32x4*)(qp + 16 * st); }
    if (MODE == 0) {
#pragma unroll
        for (int st = 0; st < 4; ++st) rot8(qf[st], qf[st + 4], rope + ((size_t)t * 64 + 16 * st + 8 * hh) * 2);
    }
    const int ks = tid >> 3, kc = tid & 7;
    const bf16_t* kg = H + (rowb + ks) * pitch + kcol + 8 * kc;
    const int vdb = (DV == 128) ? 16 * wid : 8 * wid;
    const bf16_t* vg = H + (rowb + lane) * pitch + vcol + vdb;
    u32x4 kr0, kr1, vr0, vr1;
    kr1 = (u32x4){0u, 0u, 0u, 0u}; vr1 = kr1;
#define LOAD_TILE(kt) do { const size_t off_ = (size_t)(kt) * 64 * pitch; kr0 = *(const u32x4*)(kg + off_); if (KD == 128) kr1 = *(const u32x4*)(kg + off_ + 64); \
        vr0 = *(const u32x4*)(vg + off_); if (DV == 128) vr1 = *(const u32x4*)(vg + off_ + 8); } while (0)
#define WRITE_TILE(kt, buf) do { LAS unsigned char* Kb_ = lds + (buf) * BUFB; LAS unsigned char* Vb_ = Kb_ + VOFF; \
        if (MODE == 0) rot8(kr0, kr1, rope + ((size_t)((kt) * 64 + ks) * 64 + 8 * kc) * 2); \
        *(LAS u32x4*)(Kb_ + ks * KP + kc * 16) = kr0; if (KD == 128) *(LAS u32x4*)(Kb_ + ks * KP + 128 + kc * 16) = kr1; \
        _Pragma("unroll") for (int i_ = 0; i_ < 4; ++i_) { \
            *(LAS unsigned short*)(Vb_ + (vdb + 2 * i_) * VP + lane * 2) = (unsigned short)(vr0[i_] & 0xffffu); \
            *(LAS unsigned short*)(Vb_ + (vdb + 2 * i_ + 1) * VP + lane * 2) = (unsigned short)(vr0[i_] >> 16); \
            if (DV == 128) { *(LAS unsigned short*)(Vb_ + (vdb + 8 + 2 * i_) * VP + lane * 2) = (unsigned short)(vr1[i_] & 0xffffu); \
                             *(LAS unsigned short*)(Vb_ + (vdb + 8 + 2 * i_ + 1) * VP + lane * 2) = (unsigned short)(vr1[i_] >> 16); } } } while (0)

    f32x16 oacc[NDT];
#pragma unroll
    for (int dt = 0; dt < NDT; ++dt)
#pragma unroll
        for (int i = 0; i < 16; ++i) oacc[dt][i] = 0.f;
    float mrun[NMAP], lrun[NMAP], cmul[NMAP];
#pragma unroll
    for (int p = 0; p < NMAP; ++p) { mrun[p] = -INFINITY; lrun[p] = 0.f; cmul[p] = 0.f; }
    float Rrun = 0.f;
    const float lg2 = (MODE == 0) ? (hd == 0 ? -4.580368961312e-02f : (hd == 1 ? -2.272007650008e-02f : (hd == 2 ? -1.131531322783e-02f : -5.646563141142e-03f))) : 0.f;
    const float lam_init = (layer == 1) ? 0.3555090676f : 0.5560582042f;

    const int nkt = qb * 4 + 4;
    constexpr int NPASS = (MODE == 2) ? 2 : 1;
    for (int pass = 0; pass < NPASS; ++pass) {
    const bool statpass = (MODE == 2) && (pass == 0);
    if (MODE == 2 && pass == 1) {
        const int li = layer >> 1;
        const float d1 = wave_sum(a.in[5][li * 64 + lane] * a.in[6][li * 64 + lane]);
        const float d2 = wave_sum(a.in[7][li * 64 + lane] * a.in[8][li * 64 + lane]);
        const float lam = expf(d1) - expf(d2) + lam_init;
        cmul[0] = 1.f / lrun[0]; cmul[NMAP - 1] = lam / lrun[NMAP - 1];
    }
    if (MODE != 2) LOAD_TILE(nkt - 1);
    LAS unsigned* dflag = (LAS unsigned*)(lds + 90112 + 64);
    for (int it = 0; it < nkt; ++it) {
        const int kt = nkt - 1 - it, buf = it & 1;
        if (MODE == 2) LOAD_TILE(kt);
        WRITE_TILE(kt, buf);
        __syncthreads();
        if (MODE == 1 && it > 0) {
            const LAS unsigned* df = dflag + ((it - 1) & 1) * 8;
            const unsigned alld = df[0] & df[1] & df[2] & df[3] & df[4] & df[5] & df[6] & df[7];
            if (alld) break;
        }
        if (MODE != 2 && it + 1 < nkt) LOAD_TILE(kt - 1);
        LAS unsigned char* Kb = lds + buf * BUFB; LAS unsigned char* Vb = Kb + VOFF;
#pragma unroll 1
        for (int subi = 0; subi < 2; ++subi) {
            const int sub = 1 - subi;
            const int s0 = kt * 64 + 32 * sub;
            if (s0 > t0) continue;
            const int relb = t0 - s0 + r - 4 * hh;
            __builtin_amdgcn_sched_barrier(0);
            float pv[16];
#pragma unroll
            for (int p = 0; p < NMAP; ++p) {
                f32x16 sacc;
#pragma unroll
                for (int i = 0; i < 16; ++i) sacc[i] = 0.f;
                constexpr int NST = NQS / NMAP;
#pragma unroll
                for (int st = 0; st < NST; ++st) {
                    const int sq = p * NST + st;
                    const bf16x8 kf = *(const LAS bf16x8*)(Kb + (32 * sub + r) * KP + (16 * sq + 8 * hh) * 2);
                    sacc = MFMA32(kf, __builtin_bit_cast(bf16x8, qf[sq]), sacc);
                }
                if (MODE == 0) {
#pragma unroll
                    for (int i = 0; i < 16; ++i) { const int rel = relb - ((i & 3) + 8 * (i >> 2));
                        const float f = __builtin_amdgcn_exp2f((float)rel * lg2) * 0.08838834764831845f;
                        pv[i] = (rel >= 0) ? sacc[i] * f : 0.f; }
                } else if (MODE == 1) {
                    float L[16], ls[16], c[16], gs[4], pg[4], suf[4];
#pragma unroll
                    for (int i = 0; i < 16; ++i) { const int rel = relb - ((i & 3) + 8 * (i >> 2));
                        const float z = sacc[i] * 0.125f; const float lp = __logf(1.f + __expf(-fabsf(z)));
                        const float lsi = fminf(z, 0.f) - lp; ls[i] = lsi; L[i] = (rel > 0) ? (lsi - z) : 0.f; }
#pragma unroll
                    for (int g = 0; g < 4; ++g) { c[4 * g + 3] = 0.f; c[4 * g + 2] = L[4 * g + 3]; c[4 * g + 1] = c[4 * g + 2] + L[4 * g + 2]; c[4 * g] = c[4 * g + 1] + L[4 * g + 1];
                        gs[g] = c[4 * g] + L[4 * g]; pg[g] = __shfl_xor(gs[g], 32); }
                    float run = 0.f;
#pragma unroll
                    for (int g = 3; g >= 0; --g) { suf[g] = run + (hh == 0 ? pg[g] : 0.f); run += gs[g] + pg[g]; }
#pragma unroll
                    for (int i = 0; i < 16; ++i) { const int rel = relb - ((i & 3) + 8 * (i >> 2));
                        const float e = __expf(ls[i] + Rrun + suf[i >> 2] + c[i]); pv[i] = (rel > 0) ? e : 0.f; }
                    Rrun += run;
                } else {
                    const bool far = (t0 - s0 - 31) >= 128;
                    float sv[16]; float mx = -INFINITY;
                    if (far) {
                        const float bfar = biasT[128];
#pragma unroll
                        for (int i = 0; i < 16; ++i) { const float v = sacc[i] * (0.125f * LOG2E) + bfar; sv[i] = v; mx = fmaxf(mx, v); }
                    } else {
#pragma unroll
                        for (int i = 0; i < 16; ++i) { const int rel = relb - ((i & 3) + 8 * (i >> 2));
                            const int ri = rel < 0 ? 0 : (rel > 128 ? 128 : rel);
                            float v = sacc[i] * (0.125f * LOG2E) + biasT[ri];
                            if (rel < 0) v = -INFINITY;
                            sv[i] = v; mx = fmaxf(mx, v); }
                    }
                    if (statpass) {
                        mx = fmaxf(mx, __shfl_xor(mx, 32));
                        const float mnew = fmaxf(mrun[p], mx);
                        const float al = __builtin_amdgcn_exp2f(mrun[p] - mnew);
                        float sm = 0.f;
#pragma unroll
                        for (int i = 0; i < 16; ++i) sm += __builtin_amdgcn_exp2f(sv[i] - mnew);
                        sm += __shfl_xor(sm, 32);
                        lrun[p] = lrun[p] * al + sm; mrun[p] = mnew;
                    } else {
                        const float mm = mrun[p], cc = cmul[p];
                        if (p == 0) {
#pragma unroll
                            for (int i = 0; i < 16; ++i) pv[i] = __builtin_amdgcn_exp2f(sv[i] - mm) * cc;
                        } else {
#pragma unroll
                            for (int i = 0; i < 16; ++i) pv[i] -= __builtin_amdgcn_exp2f(sv[i] - mm) * cc;
                        }
                    }
                }
            }
            __builtin_amdgcn_sched_barrier(0);
            if (statpass) continue;
#pragma unroll
            for (int ss = 0; ss < 2; ++ss) {
                const bf16x8 pb = pack8(pv[8 * ss], pv[8 * ss + 1], pv[8 * ss + 2], pv[8 * ss + 3], pv[8 * ss + 4], pv[8 * ss + 5], pv[8 * ss + 6], pv[8 * ss + 7]);
#pragma unroll
                for (int dt = 0; dt < NDT; ++dt) {
                    const LAS unsigned char* vp = Vb + (32 * dt + r) * VP + (32 * sub + 16 * ss + 4 * hh) * 2;
                    const s16x4 lo = *(const LAS s16x4*)vp; const s16x4 hi = *(const LAS s16x4*)(vp + 16);
                    const bf16x8 vf = __builtin_shufflevector(lo, hi, 0, 1, 2, 3, 4, 5, 6, 7);
                    oacc[dt] = MFMA32(vf, pb, oacc[dt]);
                }
            }
        }
        if (MODE == 1) { const int dn = __all(Rrun < -120.f); if (lane == 0) dflag[(it & 1) * 8 + wid] = dn ? 1u : 0u; }
    }
    }
#undef LOAD_TILE
#undef WRITE_TILE
    bf16_t* yrow = Y + (rowb + t) * D_MODEL + ycol + 4 * hh;
    if (MODE == 0) {
        float s = 0.f;
#pragma unroll
        for (int dt = 0; dt < NDT; ++dt)
#pragma unroll
            for (int i = 0; i < 16; ++i) s += oacc[dt][i];
        s += __shfl_xor(s, 32);
        const float mean = s * (1.f / 128.f); float q = 0.f;
#pragma unroll
        for (int dt = 0; dt < NDT; ++dt)
#pragma unroll
            for (int i = 0; i < 16; ++i) { const float d = oacc[dt][i] - mean; q += d * d; }
        q += __shfl_xor(q, 32);
        const float rstd = 1.f / sqrtf(q * (1.f / 128.f) + LN_EPS);
        const bf16_t* grow = H + (rowb + t) * pitch + 1536 + hd * 128 + 4 * hh;
#pragma unroll
        for (int dt = 0; dt < NDT; ++dt)
#pragma unroll
            for (int g = 0; g < 4; ++g) {
                const u32x2 gw = *(const u32x2*)(grow + 32 * dt + 8 * g);
                const float g0 = bflo(gw.x), g1 = bfhi(gw.x), g2 = bflo(gw.y), g3 = bfhi(gw.y);
                const float o0 = (oacc[dt][4 * g] - mean) * rstd * (g0 / (1.f + __expf(-g0)));
                const float o1 = (oacc[dt][4 * g + 1] - mean) * rstd * (g1 / (1.f + __expf(-g1)));
                const float o2 = (oacc[dt][4 * g + 2] - mean) * rstd * (g2 / (1.f + __expf(-g2)));
                const float o3 = (oacc[dt][4 * g + 3] - mean) * rstd * (g3 / (1.f + __expf(-g3)));
                u32x2 w; w.x = cvt_pk_bf16(o0, o1); w.y = cvt_pk_bf16(o2, o3);
                *(u32x2*)(yrow + 32 * dt + 8 * g) = w;
            }
    } else if (MODE == 1) {
#pragma unroll
        for (int dt = 0; dt < NDT; ++dt)
#pragma unroll
            for (int g = 0; g < 4; ++g) {
                u32x2 w; w.x = cvt_pk_bf16(oacc[dt][4 * g], oacc[dt][4 * g + 1]); w.y = cvt_pk_bf16(oacc[dt][4 * g + 2], oacc[dt][4 * g + 3]);
                *(u32x2*)(yrow + 32 * dt + 8 * g) = w;
            }
    } else {
        const int li = layer >> 1;
        float q = 0.f;
#pragma unroll
        for (int dt = 0; dt < NDT; ++dt)
#pragma unroll
            for (int i = 0; i < 16; ++i) { const float o = oacc[dt][i]; q += o * o; }
        q += __shfl_xor(q, 32);
        const float rs = (1.f / sqrtf(q * (1.f / 128.f) + LN_EPS)) * (1.f - lam_init);
        const float* sg = a.in[9] + li * 128 + 4 * hh;
#pragma unroll
        for (int dt = 0; dt < NDT; ++dt)
#pragma unroll
            for (int g = 0; g < 4; ++g) {
                const f32x4 gv = *(const f32x4*)(sg + 32 * dt + 8 * g);
                u32x2 w; w.x = cvt_pk_bf16(oacc[dt][4 * g] * rs * gv[0], oacc[dt][4 * g + 1] * rs * gv[1]);
                w.y = cvt_pk_bf16(oacc[dt][4 * g + 2] * rs * gv[2], oacc[dt][4 * g + 3] * rs * gv[3]);
                *(u32x2*)(yrow + 32 * dt + 8 * g) = w;
            }
    }
}

DI void mixer_phase(LAS unsigned char* lds, const Args& a, const int layer) {
    PHASE_IDS;
    const bool even = (layer & 1) == 0;
    const bf16_t* H0 = (const bf16_t*)(a.ws + WS_H); bf16_t* Y0 = (bf16_t*)(a.ws + WS_Y);
    unsigned* ctr = (unsigned*)(a.ws + WS_CTL) + 64 * layer;
    LAS unsigned* qslot = (LAS unsigned*)(lds + 90112);
    const int NU = even ? 1536 : 1024;
    for (;;) {
        __syncthreads();
        if (tid == 0) qslot[0] = atomicAdd(ctr, 1u);
        __syncthreads();
        const int u = (int)qslot[0];
        if (u >= NU) break;
        const bf16_t* H = H0; bf16_t* Y = Y0; OPAQUE(H); OPAQUE(Y);
        if (even) {
            const int qi = u / 192, rem = u - qi * 192, qb = 7 - qi;
            if (rem < 64) attn_unit<0>(lds, a, H, EVEN_IN, Y, rem >> 2, rem & 3, qb, layer);
            else { const int r2 = rem - 64; attn_unit<1>(lds, a, H, EVEN_IN, Y, r2 >> 3, r2 & 7, qb, layer); }
        } else {
            const int qi = u >> 7, rem = u & 127, qb = 7 - qi;
            attn_unit<2>(lds, a, H, ODD_IN, Y, rem >> 3, rem & 7, qb, layer);
        }
    }
}

__global__ void __launch_bounds__(NTHR, 2) fwd_megakernel(Args a) {
    extern __shared__ __attribute__((aligned(16))) unsigned char lds_raw[];
    LAS unsigned char* lds = (LAS unsigned char*)lds_raw;
    cg::grid_group grid = cg::this_grid();
    const int G = gridDim.x, cid = blockIdx.x;
    float* X = a.out;
    bf16_t* XB = (bf16_t*)(a.ws + WS_XB);
    bf16_t* Hb = (bf16_t*)(a.ws + WS_H); bf16_t* Yb = (bf16_t*)(a.ws + WS_Y);
    float* RAWb = (float*)(a.ws + WS_HUP); bf16_t* Ab = (bf16_t*)(a.ws + WS_A);
    const bf16_t* Win_t = (const bf16_t*)(a.ws + WS_WIN); const bf16_t* Wout_t = (const bf16_t*)(a.ws + WS_WOUT);
    const bf16_t* Wup_t = (const bf16_t*)(a.ws + WS_WUP); const bf16_t* Wdn_t = (const bf16_t*)(a.ws + WS_WDN);

    prologue(a, lds);
    grid.sync();

    for (int l = 0; l < DEPTH; ++l) {
        const bool even = (l & 1) == 0; const int Nin = even ? EVEN_IN : ODD_IN;
        { const bf16_t* pa = XB; const bf16_t* pb = Win_t; bf16_t* po = Hb; OPAQUE(pa); OPAQUE(pb); OPAQUE(po); pg8::Gemm g{pa, pb, MTOK, Nin, D_MODEL}; pg8::StaticOrder S; S.init(MTOK, Nin, G, cid);
          pg8::EpiBf16 E{po, Nin};
          pg8::gemm_phase<pg8::EpiBf16, pg8::StaticOrder, true, true>(lds, g, S, E); }
        grid.sync();
        mixer_phase(lds, a, l);
        grid.sync();
        { const bf16_t* pa = Yb; const bf16_t* pb = Wout_t; float* po = X; OPAQUE(pa); OPAQUE(pb); OPAQUE(po); pg8::Gemm g{pa, pb, MTOK, D_MODEL, D_MODEL}; pg8::StaticOrder S; S.init(MTOK, D_MODEL, G, cid);
          pg8::EpiResid E{po, ALPHA};
          pg8::gemm_phase<pg8::EpiResid, pg8::StaticOrder, true, true>(lds, g, S, E); }
        grid.sync();
        { float* px = X; bf16_t* pxb = XB; const float* pg = a.in[15] + l * D_MODEL; const float* pbt = a.in[16] + l * D_MODEL; OPAQUE(px); OPAQUE(pxb); OPAQUE(pg); OPAQUE(pbt); ln_phase(px, pxb, pg, pbt); }
        grid.sync();
        { const bf16_t* pa = XB; const bf16_t* pb = Wup_t; bf16_t* po = Ab; float* praw = RAWb; const float* pcw = a.in[12] + (size_t)l * 3 * FF2; const float* pcb = a.in[13] + (size_t)l * FF2;
          OPAQUE(pa); OPAQUE(pb); OPAQUE(po); OPAQUE(praw); OPAQUE(pcw); OPAQUE(pcb);
          pg8::Gemm g{pa, pb, MTOK, FF2, D_MODEL}; pg8::StaticOrder S; S.init(MTOK, FF2, G, cid);
          pg8::EpiConvGate E{po, pcw, pcb, praw, lds + 131072};
          pg8::gemm_phase<pg8::EpiConvGate, pg8::StaticOrder, true, true>(lds, g, S, E); }
        grid.sync();
        { const float* praw = RAWb; bf16_t* po = Ab; const float* pcw = a.in[12] + (size_t)l * 3 * FF2; const float* pcb = a.in[13] + (size_t)l * FF2;
          OPAQUE(praw); OPAQUE(po); OPAQUE(pcw); OPAQUE(pcb); fixup_phase(praw, po, pcw, pcb); }
        grid.sync();
        { const bf16_t* pa = Ab; const bf16_t* pb = Wdn_t; float* po = X; OPAQUE(pa); OPAQUE(pb); OPAQUE(po); pg8::Gemm g{pa, pb, MTOK, D_MODEL, D_FF}; pg8::StaticOrder S; S.init(MTOK, D_MODEL, G, cid);
          pg8::EpiResid E{po, ALPHA};
          pg8::gemm_phase<pg8::EpiResid, pg8::StaticOrder, true, true>(lds, g, S, E); }
        grid.sync();
        { float* px = X; bf16_t* pxb = XB; const float* pg = a.in[17] + l * D_MODEL; const float* pbt = a.in[18] + l * D_MODEL; OPAQUE(px); OPAQUE(pxb); OPAQUE(pg); OPAQUE(pbt); ln_phase(px, pxb, pg, pbt); }
        if (l + 1 < DEPTH) convert_weights(a, l + 1, lds);
        grid.sync();
    }
}

extern "C" void kernel_launch(void* const* d_in, const int* in_sizes, int n_in, void* d_out, int out_size, void* d_ws, size_t ws_size, hipStream_t stream) {
    static int grid = 0;
    if (grid == 0) {
        if (n_in != 19 || out_size != MTOK * D_MODEL || ws_size < WS_END) { fprintf(stderr, "kernel_launch: unexpected shapes (n_in %d out %d ws %zu)\n", n_in, out_size, ws_size); grid = -1; return; }
        int dev = 0, cus = 0, per_cu = 0;
        hipGetDevice(&dev);
        hipDeviceGetAttribute(&cus, hipDeviceAttributeMultiprocessorCount, dev);
        if (hipFuncSetAttribute((const void*)fwd_megakernel, hipFuncAttributeMaxDynamicSharedMemorySize, LDS_BYTES) != hipSuccess) { fprintf(stderr, "kernel_launch: hipFuncSetAttribute failed\n"); grid = -1; return; }
        if (hipOccupancyMaxActiveBlocksPerMultiprocessor(&per_cu, (const void*)fwd_megakernel, NTHR, LDS_BYTES) != hipSuccess || per_cu < 1) { fprintf(stderr, "kernel_launch: occupancy query gives %d\n", per_cu); per_cu = 1; }
        (void)hipGetLastError();
        grid = cus * 1;
    }
    if (grid < 0) return;
    Args a{};
    for (int i = 0; i < 19; ++i) a.in[i] = (const float*)d_in[i];
    a.out = (float*)d_out; a.ws = (unsigned char*)d_ws;
    void* args[] = {&a};
    hipError_t e = hipLaunchCooperativeKernel((const void*)fwd_megakernel, dim3(grid), dim3(NTHR), args, LDS_BYTES, stream);
    if (e != hipSuccess) fprintf(stderr, "cooperative launch failed: %s (grid %d)\n", hipGetErrorString(e), grid);
}
```
